# Optimizing an MI355X kernel written in HIP

```python
import math
import jax, jax.numpy as jnp
from jax import lax
import numpy as np

D_MODEL = 2048
BATCH = 8
SEQ = 2048
DEPTH = 1

RNN_WIDTH = D_MODEL
RNN_BLOCKS = 16
RNN_BLOCK = RNN_WIDTH // RNN_BLOCKS
CONV_WIDTH = 4
RG_C = 8.0
HEAD_DIM = 128
ATTN_HEADS = D_MODEL // HEAD_DIM
KV_HEADS = 4
GROUPS = ATTN_HEADS // KV_HEADS
Q_WIDTH = ATTN_HEADS * HEAD_DIM
KV_WIDTH = KV_HEADS * HEAD_DIM
IDX_HEADS = 16
IDX_DIM = 64
IDX_Q_WIDTH = IDX_HEADS * IDX_DIM
TOPK_MAX = 256
Q_BLOCK = 128
NUM_BUCKETS = 32
MAX_DISTANCE = 128
D_FF = 5504
RMS_EPS = 1e-6

IN_SPLITS = (RNN_WIDTH, RNN_WIDTH, Q_WIDTH, KV_WIDTH, KV_WIDTH, IDX_Q_WIDTH, IDX_DIM, IDX_HEADS, D_MODEL, D_MODEL)
N_IN = 2 * RNN_WIDTH + Q_WIDTH + 2 * KV_WIDTH + IDX_Q_WIDTH + IDX_DIM + IDX_HEADS + 2 * D_MODEL

kernel_name = "hybrid_rglru_dsa_macaron"


def rms_norm(x, g):
    xf = x.astype(jnp.float32)
    y = xf * lax.rsqrt(jnp.mean(xf * xf, axis=-1, keepdims=True) + RMS_EPS)
    return (y * g.astype(jnp.float32)).astype(x.dtype)


def swiglu(x, w_gate, w_up, w_down):
    return (jax.nn.silu(x @ w_gate) * (x @ w_up)) @ w_down


def causal_depthwise_conv(x, w, b):
    s = x.shape[1]
    xp = jnp.pad(x, ((0, 0), (CONV_WIDTH - 1, 0), (0, 0)))
    y = b
    for k in range(CONV_WIDTH):
        y = y + xp[:, k:k + s] * w[k]
    return y


def rg_lru(x, w_a, b_a, w_x, b_x, lam):
    bsz, s, w = x.shape
    xb = x.reshape(bsz, s, RNN_BLOCKS, RNN_BLOCK)
    r = jax.nn.sigmoid(jnp.einsum('bsnc,ncd->bsnd', xb, w_a).reshape(bsz, s, w) + b_a).astype(jnp.float32)
    i = jax.nn.sigmoid(jnp.einsum('bsnc,ncd->bsnd', xb, w_x).reshape(bsz, s, w) + b_x).astype(jnp.float32)
    log_a = -RG_C * r * jax.nn.softplus(-lam.astype(jnp.float32))
    a = jnp.exp(log_a)
    mult = jnp.sqrt(-jnp.expm1(2.0 * log_a))
    u = mult * (i * x.astype(jnp.float32))

    def combine(left, right):
        a_l, b_l = left
        a_r, b_r = right
        return a_l * a_r, a_r * b_l + b_r

    _, h = lax.associative_scan(combine, (a, u), axis=1)
    return h.astype(x.dtype)


def t5_causal_bucket(rel):
    n = jnp.maximum(rel, 0)
    max_exact = NUM_BUCKETS // 2
    nf = jnp.maximum(n, 1).astype(jnp.float32)
    large = max_exact + (jnp.log(nf / max_exact) / math.log(MAX_DISTANCE / max_exact)
                         * (NUM_BUCKETS - max_exact)).astype(jnp.int32)
    large = jnp.minimum(large, NUM_BUCKETS - 1)
    return jnp.where(n < max_exact, n, large)


def dsa_attention(q, k, v, iq, ik, iw, rel_bias):
    bsz, s, _ = q.shape
    k_top = min(TOPK_MAX, s // 4)
    nb = s // Q_BLOCK
    k = k.reshape(bsz, s, KV_HEADS, HEAD_DIM)
    v = v.reshape(bsz, s, KV_HEADS, HEAD_DIM)
    q_blk = jnp.moveaxis(q.reshape(bsz, nb, Q_BLOCK, KV_HEADS, GROUPS, HEAD_DIM), 1, 0)
    iq_blk = jnp.moveaxis(iq.reshape(bsz, nb, Q_BLOCK, IDX_HEADS, IDX_DIM), 1, 0)
    iw_blk = jnp.moveaxis((iw * (IDX_HEADS ** -0.5)).reshape(bsz, nb, Q_BLOCK, IDX_HEADS), 1, 0)
    pos_blk = jnp.arange(s, dtype=jnp.int32).reshape(nb, Q_BLOCK)
    key_pos = jnp.arange(s, dtype=jnp.int32)
    scale = HEAD_DIM ** -0.5
    idx_scale = IDX_DIM ** -0.5

    def block_fn(args):
        qb, iqb, iwb, pos = args
        dots = jnp.einsum('bqhd,bsd->bqhs', iqb, ik).astype(jnp.float32) * idx_scale
        scores = jnp.einsum('bqhs,bqh->bqs', jax.nn.relu(dots), iwb.astype(jnp.float32))
        causal = key_pos[None, None, :] <= pos[None, :, None]
        scores = jnp.where(causal, scores, -jnp.inf)
        _, idx = lax.top_k(scores, k_top)
        kg = jax.vmap(lambda kb, ib: kb[ib])(k, idx)
        vg = jax.vmap(lambda vb, ib: vb[ib])(v, idx)
        logits = jnp.einsum('bqhgd,bqshd->bqhgs', qb, kg).astype(jnp.float32) * scale
        rel = pos[None, :, None] - idx
        bias = rel_bias[t5_causal_bucket(rel)].astype(jnp.float32)
        bias = jnp.transpose(bias.reshape(bsz, Q_BLOCK, k_top, KV_HEADS, GROUPS), (0, 1, 3, 4, 2))
        valid = (rel >= 0)[:, :, None, None, :]
        logits = jnp.where(valid, logits + bias, jnp.finfo(jnp.float32).min)
        p = jax.nn.softmax(logits, axis=-1).astype(vg.dtype)
        out = jnp.einsum('bqhgs,bqshd->bqhgd', p, vg)
        return out.reshape(bsz, Q_BLOCK, Q_WIDTH)

    outs = lax.map(block_fn, (q_blk, iq_blk, iw_blk, pos_blk))
    return jnp.moveaxis(outs, 0, 1).reshape(bsz, s, Q_WIDTH)


def hybrid_mixer(h, w_in, conv_w, conv_b, rg_w_a, rg_b_a, rg_w_x, rg_b_x, rg_lambda,
                 rel_bias, w_proj_rnn, w_proj_attn, w_out):
    proj = h @ w_in
    split_pts = [int(p) for p in np.cumsum(IN_SPLITS)[:-1]]
    rx, rgate, q, k, v, iq, ik, iw, g_rnn, g_attn = jnp.split(proj, split_pts, axis=-1)
    xc = causal_depthwise_conv(rx, conv_w, conv_b)
    y_rnn = rg_lru(xc, rg_w_a, rg_b_a, rg_w_x, rg_b_x, rg_lambda) * jax.nn.gelu(rgate)
    y_attn = dsa_attention(q, k, v, iq, ik, iw, rel_bias)
    merged = (jax.nn.sigmoid(g_rnn) * (y_rnn @ w_proj_rnn)
              + jax.nn.sigmoid(g_attn) * (y_attn @ w_proj_attn))
    return merged @ w_out


def setup_inputs(seed: int = 0) -> dict:
    key = jax.random.key(seed)
    ks = jax.random.split(key, 24)
    f32 = jnp.float32

    def nrm(k, shape, fan_in):
        return jax.random.normal(k, shape, f32) * (fan_in ** -0.5)

    def gain(k, shape):
        return 1.0 + 0.02 * jax.random.normal(k, shape, f32)

    u = jax.random.uniform(ks[13], (DEPTH, RNN_WIDTH), f32, 0.9, 0.999)
    a_base = u ** (1.0 / RG_C)
    rg_lambda = jnp.log(a_base) - jnp.log1p(-a_base)
    return {
        "x": jax.random.normal(ks[0], (BATCH, SEQ, D_MODEL), f32),
        "ffn1_norm": gain(ks[1], (DEPTH, D_MODEL)),
        "ffn1_w_gate": nrm(ks[2], (DEPTH, D_MODEL, D_FF), D_MODEL),
        "ffn1_w_up": nrm(ks[3], (DEPTH, D_MODEL, D_FF), D_MODEL),
        "ffn1_w_down": nrm(ks[4], (DEPTH, D_FF, D_MODEL), D_FF),
        "mix_norm": gain(ks[5], (DEPTH, D_MODEL)),
        "w_in": nrm(ks[6], (DEPTH, D_MODEL, N_IN), D_MODEL),
        "conv_w": nrm(ks[7], (DEPTH, CONV_WIDTH, RNN_WIDTH), CONV_WIDTH),
        "conv_b": 0.01 * jax.random.normal(ks[8], (DEPTH, RNN_WIDTH), f32),
        "rg_w_a": nrm(ks[9], (DEPTH, RNN_BLOCKS, RNN_BLOCK, RNN_BLOCK), RNN_BLOCK),
        "rg_b_a": 0.01 * jax.random.normal(ks[10], (DEPTH, RNN_WIDTH), f32),
        "rg_w_x": nrm(ks[11], (DEPTH, RNN_BLOCKS, RNN_BLOCK, RNN_BLOCK), RNN_BLOCK),
        "rg_b_x": 0.01 * jax.random.normal(ks[12], (DEPTH, RNN_WIDTH), f32),
        "rg_lambda": rg_lambda,
        "rel_bias": 0.5 * jax.random.normal(ks[14], (NUM_BUCKETS, ATTN_HEADS), f32),
        "w_proj_rnn": nrm(ks[15], (DEPTH, RNN_WIDTH, D_MODEL), RNN_WIDTH),
        "w_proj_attn": nrm(ks[16], (DEPTH, Q_WIDTH, D_MODEL), Q_WIDTH),
        "w_out": nrm(ks[17], (DEPTH, D_MODEL, D_MODEL), D_MODEL),
        "ffn2_norm": gain(ks[18], (DEPTH, D_MODEL)),
        "ffn2_w_gate": nrm(ks[19], (DEPTH, D_MODEL, D_FF), D_MODEL),
        "ffn2_w_up": nrm(ks[20], (DEPTH, D_MODEL, D_FF), D_MODEL),
        "ffn2_w_down": nrm(ks[21], (DEPTH, D_FF, D_MODEL), D_FF),
        "final_norm": gain(ks[22], (D_MODEL,)),
    }


def reference(x, ffn1_norm, ffn1_w_gate, ffn1_w_up, ffn1_w_down, mix_norm, w_in, conv_w, conv_b,
              rg_w_a, rg_b_a, rg_w_x, rg_b_x, rg_lambda, rel_bias, w_proj_rnn, w_proj_attn, w_out,
              ffn2_norm, ffn2_w_gate, ffn2_w_up, ffn2_w_down, final_norm):
    for l in range(DEPTH):
        x = x + 0.5 * swiglu(rms_norm(x, ffn1_norm[l]), ffn1_w_gate[l], ffn1_w_up[l], ffn1_w_down[l])
        x = x + hybrid_mixer(rms_norm(x, mix_norm[l]), w_in[l], conv_w[l], conv_b[l],
                             rg_w_a[l], rg_b_a[l], rg_w_x[l], rg_b_x[l], rg_lambda[l],
                             rel_bias, w_proj_rnn[l], w_proj_attn[l], w_out[l])
        x = x + 0.5 * swiglu(rms_norm(x, ffn2_norm[l]), ffn2_w_gate[l], ffn2_w_up[l], ffn2_w_down[l])
    return rms_norm(x, final_norm)
```

```cpp
#include <hip/hip_runtime.h>
#include <cstdio>
#include <cstdint>
#define MK_N_LAUNCHES 15
namespace pg8 {
#define PG8_LAS __attribute__((address_space(3)))
typedef unsigned short bf16_t;
typedef short bf16x8 __attribute__((ext_vector_type(8)));
typedef float f32x4 __attribute__((ext_vector_type(4)));
typedef unsigned u32x4 __attribute__((ext_vector_type(4)));
constexpr int BM = 256, BK = 64, HALF = 128, HTB = HALF * BK * 2  , STAGE_BYTES = 8 * HTB, NXCD = 8, WGM = 8;

__host__ __device__ __forceinline__ int lds_byte(int r, int c) { const int st = (r >> 4) * 2 + (c >> 5), rr = r & 15, cc = c & 31, ob = rr * 64 + cc * 2; return st * 1024 + (ob ^ (((ob >> 9) & 1) << 5)); }
__host__ __device__ __forceinline__ void stage_rc(int b, int& R, int& C) { const int st = b / 1024, sb = b % 1024, swz = sb ^ (((sb >> 9) & 1) << 5); R = (st >> 1) * 16 + swz / 64; C = (st & 1) * 32 + (swz % 64) / 2; }
__host__ __device__ __forceinline__ int perm32(int rho) { const int n = rho >> 4, i = rho & 15; return 8 * (i >> 2) + 4 * n + (i & 3); }

struct Unit { int pm, pn; };
struct Gemm { const bf16_t* A; const bf16_t* Bt; int M, N, K; };

struct StaticOrder {
    int nM, nN, nwg, G, c;
    __host__ __device__ void init(int M, int N, int G_, int c_) { nM = M / BM; nN = N / BM; nwg = nM * nN; G = G_; c = c_; }
    __host__ __device__ bool next(int i, Unit& u) const {
        const long L = (long)i * G + c; if (L >= nwg) return false;
        int wgid = (int)L; { const int q = nwg / NXCD, r = nwg % NXCD, xcd = wgid % NXCD, off = wgid / NXCD; wgid = (xcd < r ? xcd * (q + 1) : r * (q + 1) + (xcd - r) * q) + off; }
        const int nig = WGM * nN, gid = wgid / nig, fm = gid * WGM, gsz = (nM - fm) < WGM ? (nM - fm) : WGM;
        u.pm = fm + ((wgid % nig) % gsz); u.pn = (wgid % nig) / gsz; return true;
    }
    __device__ __forceinline__ void a_ready(const Unit&) const {}
    __device__ __forceinline__ void done(const Unit&) const {}
};
__device__ __forceinline__ unsigned cvt_pk_bf16(float lo, float hi) { unsigned r; asm volatile("v_cvt_pk_bf16_f32 %0, %1, %2" : "=v"(r) : "v"(lo), "v"(hi)); return r; }
typedef float f32x2 __attribute__((ext_vector_type(2)));
template <class Epi, class Sched, bool ALIGN_EPI = false, bool SP2 = false>
__device__ __forceinline__ void gemm_phase(PG8_LAS unsigned char* lds, const Gemm g, const Sched& S, const Epi& E) {
    const int tid = threadIdx.x, wid = __builtin_amdgcn_readfirstlane(tid >> 6), lane = tid & 63, wr = wid >> 2, wc = wid & 3, fr = lane & 15, fq = lane >> 4;
    const int K = g.K, nt = K / BK;
    unsigned voffA[2], voffB[2];
#pragma unroll
    for (int i = 0; i < 2; ++i) { int R, C; stage_rc(tid * 16 + i * 8192, R, C); const int Rb = Epi::PERM ? ((R & ~31) + perm32(R & 31)) : R;
        voffA[i] = (unsigned)(R * K + C) * 2u; voffB[i] = (unsigned)(Rb * K + C) * 2u; }
    const size_t kstep = (size_t)(BK * 2);
    const size_t hstep = (size_t)HALF * K * 2;
    const size_t tstep = 2 * hstep;
    const unsigned ldsw = (unsigned)wid * 1024u;
    const int aoff = lds_byte(wr * 64 + fr, fq * 8), boff = lds_byte(wc * 32 + fr, fq * 8);
#define PG8_SA(b, h) (((b) * 2 + (h)) * HTB)
#define PG8_SB(b, h) ((4 + (b) * 2 + (h)) * HTB)
#define PG8_STAGE(bufoff, gbase, voff) do { _Pragma("unroll") for (int _i = 0; _i < 2; ++_i) \
        __builtin_amdgcn_global_load_lds((const unsigned*)((const char*)(gbase) + (voff)[_i]), (PG8_LAS unsigned*)(lds + (bufoff) + ldsw + _i * 8192), 16, 0, 0); } while (0)
#define PG8_LDA(dst, b, h) do { _Pragma("unroll") for (int m = 0; m < 4; ++m) _Pragma("unroll") for (int k = 0; k < 2; ++k) dst[m][k] = *(const PG8_LAS bf16x8*)(lds + PG8_SA(b, h) + aoff + m * 2048 + k * 1024); } while (0)
#define PG8_LDB(dst, b, h) do { _Pragma("unroll") for (int n = 0; n < 2; ++n) _Pragma("unroll") for (int k = 0; k < 2; ++k) dst[n][k] = *(const PG8_LAS bf16x8*)(lds + PG8_SB(b, h) + boff + n * 2048 + k * 1024); } while (0)
#define PG8_MMA(ai, bj, At, Bt) do { __builtin_amdgcn_s_setprio(1); _Pragma("unroll") for (int m = 0; m < 4; ++m) _Pragma("unroll") for (int n = 0; n < 2; ++n) _Pragma("unroll") for (int k = 0; k < 2; ++k) \
        acc[ai][bj][m][n] = __builtin_amdgcn_mfma_f32_16x16x32_bf16(Bt[n][k], At[m][k], acc[ai][bj][m][n], 0, 0, 0); __builtin_amdgcn_s_setprio(0); } while (0)
#define PG8_WAIT_V(n) asm volatile("s_waitcnt vmcnt(" #n ")" ::: "memory")
#define PG8_WAIT_L(n) asm volatile("s_waitcnt lgkmcnt(" #n ")" ::: "memory")
#define PG8_BAR __builtin_amdgcn_s_barrier()
#define PG8_SCHED __builtin_amdgcn_sched_barrier(0)
    Unit cur, nxt; int ui = 0;
    if (!S.next(0, cur)) return;
    f32x4 acc[2][2][4][2];
#pragma unroll
    for (int a = 0; a < 2; ++a)
#pragma unroll
        for (int b = 0; b < 2; ++b)
#pragma unroll
            for (int m = 0; m < 4; ++m)
#pragma unroll
                for (int n = 0; n < 2; ++n) acc[a][b][m][n] = (f32x4){0.f, 0.f, 0.f, 0.f};
    bf16x8 At[4][2], B0[2][2], B1[2][2];
    const char* cA = (const char*)g.A + (size_t)cur.pm * tstep; const char* cB = (const char*)g.Bt + (size_t)cur.pn * tstep;
    S.a_ready(cur);
    if constexpr (SP2) {
        PG8_STAGE(PG8_SB(0, 0), cB, voffB); PG8_STAGE(PG8_SB(0, 1), cB + hstep, voffB); PG8_STAGE(PG8_SA(0, 0), cA, voffA); PG8_STAGE(PG8_SA(0, 1), cA + hstep, voffA);
        if (wr == 1) PG8_BAR;
        PG8_WAIT_V(2); PG8_BAR;
        PG8_STAGE(PG8_SB(1, 0), cB + kstep, voffB); PG8_STAGE(PG8_SA(1, 0), cA + kstep, voffA); PG8_STAGE(PG8_SB(1, 1), cB + hstep + kstep, voffB);
        PG8_WAIT_V(6); PG8_BAR;
    } else {
        PG8_STAGE(PG8_SB(0, 0), cB, voffB); PG8_STAGE(PG8_SA(0, 0), cA, voffA); PG8_STAGE(PG8_SB(0, 1), cB + hstep, voffB); PG8_STAGE(PG8_SA(0, 1), cA + hstep, voffA);
        if (wr == 1) PG8_BAR;
        PG8_WAIT_V(4); PG8_BAR;
        PG8_STAGE(PG8_SB(1, 0), cB + kstep, voffB); PG8_STAGE(PG8_SA(1, 0), cA + kstep, voffA); PG8_STAGE(PG8_SB(1, 1), cB + hstep + kstep, voffB);
        PG8_WAIT_V(6); PG8_BAR;
    }
    for (;;) {
        const bool has_next = S.next(ui + 1, nxt);
        const char* nA = has_next ? (const char*)g.A + (size_t)nxt.pm * tstep : cA; const char* nB = has_next ? (const char*)g.Bt + (size_t)nxt.pn * tstep : cB;
        for (int t = 0; t < nt; t += 2) {
            const bool last = (t == nt - 2);
            const char* a1 = cA + (size_t)(t + 1) * kstep;
            const char* a2 = last ? nA : cA + (size_t)(t + 2) * kstep; const char* b2 = last ? nB : cB + (size_t)(t + 2) * kstep;
            const char* a3 = a2 + kstep; const char* b3 = b2 + kstep;
            if (last && has_next) S.a_ready(nxt);
            if constexpr (SP2) {
            PG8_LDB(B0, 0, 0); PG8_LDB(B1, 0, 1); PG8_SCHED; PG8_LDA(At, 0, 0); PG8_STAGE(PG8_SA(1, 1), a1 + hstep, voffA);
            PG8_WAIT_V(8); PG8_WAIT_L(0); PG8_BAR; PG8_MMA(0, 0, At, B0); PG8_MMA(0, 1, At, B1); PG8_BAR; PG8_SCHED;
            PG8_LDA(At, 0, 1); PG8_STAGE(PG8_SB(0, 0), b2, voffB); PG8_STAGE(PG8_SB(0, 1), b2 + hstep, voffB); PG8_STAGE(PG8_SA(0, 0), a2, voffA);
            PG8_WAIT_V(8); PG8_WAIT_L(0); PG8_BAR; PG8_MMA(1, 0, At, B0); PG8_MMA(1, 1, At, B1); PG8_BAR; PG8_SCHED;
            PG8_LDB(B0, 1, 0); PG8_LDB(B1, 1, 1); PG8_SCHED; PG8_LDA(At, 1, 0); PG8_STAGE(PG8_SA(0, 1), a2 + hstep, voffA);
            PG8_WAIT_V(8); PG8_WAIT_L(0); PG8_BAR; PG8_MMA(0, 0, At, B0); PG8_MMA(0, 1, At, B1); PG8_BAR; PG8_SCHED;
            PG8_LDA(At, 1, 1); PG8_STAGE(PG8_SB(1, 0), b3, voffB); PG8_STAGE(PG8_SB(1, 1), b3 + hstep, voffB); PG8_STAGE(PG8_SA(1, 0), a3, voffA);
            PG8_WAIT_V(8); PG8_WAIT_L(0); PG8_BAR; PG8_MMA(1, 0, At, B0); PG8_MMA(1, 1, At, B1); PG8_BAR; PG8_SCHED;
            } else {
            PG8_LDB(B0, 0, 0); PG8_SCHED; PG8_LDA(At, 0, 0); PG8_STAGE(PG8_SA(1, 1), a1 + hstep, voffA);
            PG8_WAIT_L(8); PG8_BAR; PG8_WAIT_L(0); PG8_MMA(0, 0, At, B0); PG8_BAR; PG8_SCHED;
            PG8_LDB(B1, 0, 1); PG8_STAGE(PG8_SB(0, 0), b2, voffB);
            PG8_BAR; PG8_WAIT_L(0); PG8_MMA(0, 1, At, B1); PG8_BAR;
            PG8_LDA(At, 0, 1); PG8_STAGE(PG8_SA(0, 0), a2, voffA);
            PG8_BAR; PG8_WAIT_L(0); PG8_MMA(1, 0, At, B0); PG8_BAR; PG8_SCHED;
            PG8_STAGE(PG8_SB(0, 1), b2 + hstep, voffB);
            PG8_WAIT_V(6); PG8_BAR; PG8_MMA(1, 1, At, B1); PG8_BAR;
            PG8_LDB(B0, 1, 0); PG8_SCHED; PG8_LDA(At, 1, 0); PG8_STAGE(PG8_SA(0, 1), a2 + hstep, voffA);
            PG8_WAIT_L(8); PG8_BAR; PG8_WAIT_L(0); PG8_MMA(0, 0, At, B0); PG8_BAR; PG8_SCHED;
            PG8_LDB(B1, 1, 1); PG8_STAGE(PG8_SB(1, 0), b3, voffB);
            PG8_BAR; PG8_WAIT_L(0); PG8_MMA(0, 1, At, B1); PG8_BAR;
            PG8_LDA(At, 1, 1); PG8_STAGE(PG8_SA(1, 0), a3, voffA);
            PG8_BAR; PG8_WAIT_L(0); PG8_MMA(1, 0, At, B0); PG8_BAR; PG8_SCHED;
            PG8_STAGE(PG8_SB(1, 1), b3 + hstep, voffB);
            PG8_WAIT_V(6); PG8_BAR; PG8_MMA(1, 1, At, B1); PG8_BAR;
            }
        }
        if constexpr (ALIGN_EPI) { if (wr == 0) PG8_BAR; }
        if constexpr (!Epi::AFTER_DRAIN) { E(acc, cur, wr, wc, fr, fq); S.done(cur); }
        if (!has_next) break;
#pragma unroll
        for (int a = 0; a < 2; ++a)
#pragma unroll
            for (int b = 0; b < 2; ++b)
#pragma unroll
                for (int m = 0; m < 4; ++m)
#pragma unroll
                    for (int n = 0; n < 2; ++n) acc[a][b][m][n] = (f32x4){0.f, 0.f, 0.f, 0.f};
        cur = nxt; cA = nA; cB = nB; ++ui;
        if constexpr (ALIGN_EPI) { if (wr == 1) PG8_BAR; }
    }
    PG8_WAIT_V(0);
    if constexpr (!ALIGN_EPI) { if (wr == 0) PG8_BAR; }
    PG8_BAR;
    if constexpr (Epi::AFTER_DRAIN) { E.fused(acc, cur, wr, wc, fr, fq, lds, wid, lane); S.done(cur); }
#undef PG8_SA
#undef PG8_SB
#undef PG8_STAGE
#undef PG8_LDA
#undef PG8_LDB
#undef PG8_MMA
#undef PG8_WAIT_V
#undef PG8_WAIT_L
#undef PG8_BAR
#undef PG8_SCHED
}
}

constexpr int NWAVES = 8, NTHR = 512;
constexpr int BATCH = 8, SEQ = 2048, DM = 2048, MTOK = BATCH * SEQ, DFF = 5504, NGU = 2 * DFF;
constexpr int NIN = 12368, NA_VALID = 8272, NA = 8448, NB = 4096;
constexpr int KVW = 512, IQW = 1024;
constexpr float RMS_EPS = 1e-6f;
constexpr float LOG2E = 1.4426950408889634f;

constexpr size_t MiB = 1u << 20;
constexpr size_t WS_CTL = 0, CTL_ZERO_BYTES = 1 * MiB;
constexpr size_t WS_WGU = 2 * MiB;
constexpr size_t WS_WD = 45 * MiB;
constexpr size_t WS_WA = 67 * MiB;
constexpr size_t WS_WB = 100 * MiB;
constexpr size_t WS_WPR = 116 * MiB, WS_WPA = 124 * MiB, WS_WOUT = 132 * MiB;
constexpr size_t WS_RGA = 140 * MiB, WS_RGX = WS_RGA + MiB / 2;
constexpr size_t WS_H = 142 * MiB;
constexpr size_t WS_ACT = 206 * MiB;
constexpr size_t WS_RX = 206 * MiB;
constexpr size_t WS_RG = 270 * MiB;
constexpr size_t WS_Q = 334 * MiB;
constexpr size_t WS_K = 398 * MiB;
constexpr size_t WS_VT = 414 * MiB;
constexpr size_t WS_IQ = 430 * MiB;
constexpr size_t WS_SGA = 398 * MiB;
constexpr size_t WS_IK = 462 * MiB;
constexpr size_t WS_IW = 464 * MiB;
constexpr size_t WS_MASK = 466 * MiB;
constexpr size_t WS_END = 470 * MiB;
static_assert(WS_ACT + (size_t)MTOK * DFF * 2 <= WS_END - 0 && WS_ACT + (size_t)MTOK * DFF * 2 == 378 * MiB, "act");
static_assert(WS_WGU + (size_t)NGU * DM * 2 == WS_WD && WS_WD + (size_t)DM * DFF * 2 <= WS_WA && WS_WA + (size_t)NA * DM * 2 == WS_WB, "weights map");
constexpr int CW_BAR = 4096;

constexpr int RING_OFF = 0, RING_BYTES = 131072;
constexpr int LDSCTL_OFF = RING_BYTES, MISC_OFF = LDSCTL_OFF + 320;
constexpr int LDS_BYTES = 147456;
#define GAS __attribute__((address_space(1)))
#define LAS __attribute__((address_space(3)))
typedef unsigned short bf16;
typedef unsigned v4u __attribute__((ext_vector_type(4)));
typedef float f32x4 __attribute__((ext_vector_type(4)));
typedef short bf16x8 __attribute__((ext_vector_type(8)));
typedef GAS unsigned gu32;
typedef GAS unsigned long long gu64;
#define RLX_AGENT __ATOMIC_RELAXED, __HIP_MEMORY_SCOPE_AGENT
#define LDS_WAIT() asm volatile("s_waitcnt lgkmcnt(0)" ::: "memory")
#define VM_WAIT() asm volatile("s_waitcnt vmcnt(0)" ::: "memory")
__device__ __forceinline__ unsigned long long rt() { return __builtin_amdgcn_s_memrealtime(); }
__device__ __forceinline__ unsigned f2bf(float f) { unsigned u = __builtin_bit_cast(unsigned, f); return (u + 0x7fffu + ((u >> 16) & 1u)) >> 16; }
__device__ __forceinline__ unsigned pk2(float lo, float hi) { return f2bf(lo) | (f2bf(hi) << 16); }

#define XB_TMO      128
#define XB_XCNT(j)  (256  + 64 * (j))
#define XB_XSUB(j)  (1280 + 64 * (j))
#define XB_XGEN(j)  (2304 + 64 * (j))
#define XB_TOP      3328
#define XB_TOPGEN   3392
#define XCD_BAR_WORDS 3456
#define XB_SPIN_CAP (1u << 18)

__device__ __forceinline__ unsigned xb_ld(unsigned* p)              { return __hip_atomic_load(p, __ATOMIC_RELAXED, __HIP_MEMORY_SCOPE_AGENT); }
__device__ __forceinline__ unsigned xb_add(unsigned* p, unsigned v) { return __hip_atomic_fetch_add(p, v, __ATOMIC_RELAXED, __HIP_MEMORY_SCOPE_AGENT); }
__device__ __forceinline__ unsigned xb_xcc_id() { return (unsigned)__builtin_amdgcn_s_getreg((3 << 11) | 20) & 0xFu; }
#define XB_SPIN(cond, bar) do { unsigned _sp = 0; while (cond) { __builtin_amdgcn_s_sleep(1); \
    if ((++_sp & 255u) == 0u) { if (xb_ld(&(bar)[XB_TMO])) break; if (_sp > XB_SPIN_CAP) { atomicAdd(&(bar)[XB_TMO], 1u); break; } } } } while (0)

struct XcdBarrier {
    unsigned* bar; unsigned x;
    volatile LAS unsigned* st;
};

__device__ __forceinline__ XcdBarrier xcd_barrier_post(unsigned* bar, volatile LAS unsigned* st) {
    XcdBarrier b; b.bar = bar; b.x = xb_xcc_id(); b.st = st;
    if (threadIdx.x == 0) (void)xb_add(&bar[XB_XCNT(b.x)], 1u);
    return b;
}
__device__ __forceinline__ void xcd_barrier_complete(unsigned* bar, unsigned x, unsigned& nloc, unsigned& nx) {
    const unsigned G = gridDim.x * gridDim.y * gridDim.z;
    unsigned sum, cnt, mine, sp = 0u;
    for (;;) {
        sum = 0u; cnt = 0u; mine = 0u;
#pragma unroll
        for (unsigned j = 0; j < 16; ++j) { const unsigned c = xb_ld(&bar[XB_XCNT(j)]); sum += c; cnt += (c > 0u) ? 1u : 0u; mine = (j == x) ? c : mine; }
        if (sum == G) break;
        __builtin_amdgcn_s_sleep(1);
        if ((++sp & 255u) == 0u) { if (xb_ld(&bar[XB_TMO])) break; if (sp > XB_SPIN_CAP) { atomicAdd(&bar[XB_TMO], 1u); break; } }
    }
    nloc = mine > 0u ? mine : 1u; nx = cnt > 0u ? cnt : 1u;
}

__device__ __forceinline__ void xcd_barrier(const XcdBarrier& b) {
    asm volatile("s_waitcnt vmcnt(0)" ::: "memory");
    __syncthreads();
    if (threadIdx.x == 0) {
        unsigned* bar = b.bar;
        __builtin_amdgcn_s_waitcnt(0);
        unsigned nloc = b.st[0], nx = b.st[1];
        if (nloc == 0u) { xcd_barrier_complete(bar, b.x, nloc, nx); b.st[0] = nloc; b.st[1] = nx; }
        const unsigned old = xb_add(&bar[XB_XSUB(b.x)], 1u);
        const unsigned gen = old / nloc;
        if (old + 1u == (gen + 1u) * nloc) {
            __builtin_amdgcn_fence(__ATOMIC_RELEASE, "agent");
            asm volatile("s_waitcnt vmcnt(0)" ::: "memory");
            const unsigned og = xb_add(&bar[XB_TOP], 1u);
            const unsigned tg = og / nx;
            if (og + 1u == (tg + 1u) * nx) xb_add(&bar[XB_TOPGEN], 1u);
            else XB_SPIN(xb_ld(&bar[XB_TOPGEN]) == tg, bar);
            __builtin_amdgcn_fence(__ATOMIC_ACQUIRE, "agent");
            xb_add(&bar[XB_XGEN(b.x)], 1u);
            asm volatile("s_waitcnt vmcnt(0)" ::: "memory");
        } else {
            XB_SPIN(xb_ld(&bar[XB_XGEN(b.x)]) == gen, bar);
            __builtin_amdgcn_fence(__ATOMIC_ACQUIRE, "agent");
            asm volatile("s_waitcnt vmcnt(0)" ::: "memory");
        }
    }
    __syncthreads();
}

typedef float f32x16 __attribute__((ext_vector_type(16)));
typedef short s16x4 __attribute__((ext_vector_type(4)));
typedef unsigned v2u __attribute__((ext_vector_type(2)));

__device__ __forceinline__ float bf2f(unsigned short h) { return __builtin_bit_cast(float, (unsigned)h << 16); }
__device__ __forceinline__ float fast_exp2(float x) { return __builtin_amdgcn_exp2f(x); }
__device__ __forceinline__ float fast_rcp(float x) { return __builtin_amdgcn_rcpf(x); }
__device__ __forceinline__ float sigmoidf_(float x) { return fast_rcp(1.0f + fast_exp2(-x * LOG2E)); }
__device__ __forceinline__ float siluf_(float x) { return x * sigmoidf_(x); }
__device__ __forceinline__ float gelu_tanh(float x) { const float u = 0.7978845608028654f * (x + 0.044715f * x * x * x); return x * sigmoidf_(2.0f * u); }
typedef __bf16 bf16x2_t __attribute__((ext_vector_type(2)));
typedef float f32x2_t __attribute__((ext_vector_type(2)));
__device__ __forceinline__ unsigned cvtpk(float lo, float hi) { const f32x2_t v = {lo, hi}; const bf16x2_t b = __builtin_convertvector(v, bf16x2_t); return __builtin_bit_cast(unsigned, b); }
__device__ __forceinline__ float wave_sum(float v) {
#pragma unroll
    for (int o = 1; o < 64; o <<= 1) v += __shfl_xor(v, o);
    return v;
}

typedef pg8::f32x4 pf4;
typedef pg8::u32x4 pu4;

struct EpiSwiGLU {
    static constexpr bool PERM = true, AFTER_DRAIN = false;
    bf16* O;
    __device__ __forceinline__ void operator()(const pf4 (&acc)[2][2][4][2], const pg8::Unit& u, int wr, int wc, int fr, int fq) const {
        const int row0 = u.pm * 256 + wr * 64 + fr, col = u.pn * 128 + wc * 32 + 8 * fq;
#pragma unroll
        for (int ai = 0; ai < 2; ++ai)
#pragma unroll
            for (int m = 0; m < 4; ++m) {
                bf16* rowp = O + (size_t)(row0 + ai * 128 + m * 16) * DFF + col;
                const pf4 g0 = acc[ai][0][m][0], g1 = acc[ai][0][m][1], u0 = acc[ai][1][m][0], u1 = acc[ai][1][m][1];
                pu4 w;
                w.x = cvtpk(siluf_(g0[0]) * u0[0], siluf_(g0[1]) * u0[1]); w.y = cvtpk(siluf_(g0[2]) * u0[2], siluf_(g0[3]) * u0[3]);
                w.z = cvtpk(siluf_(g1[0]) * u1[0], siluf_(g1[1]) * u1[1]); w.w = cvtpk(siluf_(g1[2]) * u1[2], siluf_(g1[3]) * u1[3]);
                *(pu4*)rowp = w;
            }
    }
};
struct EpiResid {
    static constexpr bool PERM = false, AFTER_DRAIN = false;
    const float* base; float* out; float alpha;
    __device__ __forceinline__ void operator()(const pf4 (&acc)[2][2][4][2], const pg8::Unit& u, int wr, int wc, int fr, int fq) const {
        const int row0 = u.pm * 256 + wr * 64 + fr, col0 = u.pn * 256 + wc * 32 + 4 * fq;
#pragma unroll
        for (int ai = 0; ai < 2; ++ai)
#pragma unroll
            for (int m = 0; m < 4; ++m) {
                const size_t ro = (size_t)(row0 + ai * 128 + m * 16) * DM + col0;
#pragma unroll
                for (int bj = 0; bj < 2; ++bj)
#pragma unroll
                    for (int n = 0; n < 2; ++n) {
                        const pf4 b = *(const pf4*)(base + ro + bj * 128 + n * 16);
                        *(pf4*)(out + ro + bj * 128 + n * 16) = b + alpha * acc[ai][bj][m][n];
                    }
            }
    }
};
struct EpiProjA {
    static constexpr bool PERM = true, AFTER_DRAIN = false;
    unsigned char* ws;
    __device__ __forceinline__ void operator()(const pf4 (&acc)[2][2][4][2], const pg8::Unit& u, int wr, int wc, int fr, int fq) const {
        const int pn = u.pn, row0 = u.pm * 256 + wr * 64 + fr, cw = wc * 32 + 8 * fq;
        if (pn < 26 || (pn >= 28 && pn < 32)) {
            bf16* base; int ldc, ct; bool gel = false;
            if (pn < 8) { base = (bf16*)(ws + WS_RX); ldc = DM; ct = pn; }
            else if (pn < 16) { base = (bf16*)(ws + WS_RG); ldc = DM; ct = pn - 8; gel = true; }
            else if (pn < 24) { base = (bf16*)(ws + WS_Q); ldc = DM; ct = pn - 16; }
            else if (pn < 26) { base = (bf16*)(ws + WS_K); ldc = KVW; ct = pn - 24; }
            else { base = (bf16*)(ws + WS_IQ); ldc = IQW; ct = pn - 28; }
#pragma unroll
            for (int ai = 0; ai < 2; ++ai)
#pragma unroll
                for (int m = 0; m < 4; ++m) {
                    bf16* rowp = base + (size_t)(row0 + ai * 128 + m * 16) * ldc + ct * 256 + cw;
#pragma unroll
                    for (int bj = 0; bj < 2; ++bj) {
                        pf4 v0 = acc[ai][bj][m][0], v1 = acc[ai][bj][m][1];
                        if (gel) {
#pragma unroll
                            for (int j = 0; j < 4; ++j) { v0[j] = gelu_tanh(v0[j]); v1[j] = gelu_tanh(v1[j]); }
                        }
                        pu4 w; w.x = cvtpk(v0[0], v0[1]); w.y = cvtpk(v0[2], v0[3]); w.z = cvtpk(v1[0], v1[1]); w.w = cvtpk(v1[2], v1[3]);
                        *(pu4*)(rowp + bj * 128) = w;
                    }
                }
        } else if (pn < 28) {
            bf16* vt = (bf16*)(ws + WS_VT);
#pragma unroll
            for (int ai = 0; ai < 2; ++ai)
#pragma unroll
                for (int m = 0; m < 4; ++m) {
                    const int row = row0 + ai * 128 + m * 16, b = row >> 11, s = row & 2047;
#pragma unroll
                    for (int bj = 0; bj < 2; ++bj) {
                        const int dabs = (pn - 26) * 256 + bj * 128 + cw;
                        bf16* p = vt + ((size_t)(b * 4 + (dabs >> 7)) * 128 + (dabs & 127)) * SEQ + s;
                        const pf4 v0 = acc[ai][bj][m][0], v1 = acc[ai][bj][m][1];
#pragma unroll
                        for (int j = 0; j < 4; ++j) { p[(size_t)j * SEQ] = (bf16)f2bf(v0[j]); p[(size_t)(4 + j) * SEQ] = (bf16)f2bf(v1[j]); }
                    }
                }
        } else {
            bf16* ik = (bf16*)(ws + WS_IK); float* iw = (float*)(ws + WS_IW);
#pragma unroll
            for (int ai = 0; ai < 2; ++ai)
#pragma unroll
                for (int m = 0; m < 4; ++m) {
                    const int row = row0 + ai * 128 + m * 16;
                    const pf4 v0 = acc[ai][0][m][0], v1 = acc[ai][0][m][1];
                    if (wc < 2) { pu4 w; w.x = cvtpk(v0[0], v0[1]); w.y = cvtpk(v0[2], v0[3]); w.z = cvtpk(v1[0], v1[1]); w.w = cvtpk(v1[2], v1[3]);
                        *(pu4*)(ik + (size_t)row * 64 + cw) = w; }
                    else if (wc == 2 && fq < 2) { float* p = iw + (size_t)row * 16 + 8 * fq;
                        *(pf4*)p = v0 * 0.03125f; *(pf4*)(p + 4) = v1 * 0.03125f; }
                }
        }
    }
};
struct EpiGates {
    static constexpr bool PERM = true, AFTER_DRAIN = false;
    unsigned char* ws;
    __device__ __forceinline__ void operator()(const pf4 (&acc)[2][2][4][2], const pg8::Unit& u, int wr, int wc, int fr, int fq) const {
        const int pn = u.pn, row0 = u.pm * 256 + wr * 64 + fr, cw = wc * 32 + 8 * fq;
        bf16* base = (bf16*)(ws + (pn < 8 ? WS_RX : WS_SGA)); const int ct = pn & 7;
#pragma unroll
        for (int ai = 0; ai < 2; ++ai)
#pragma unroll
            for (int m = 0; m < 4; ++m) {
                bf16* rowp = base + (size_t)(row0 + ai * 128 + m * 16) * DM + ct * 256 + cw;
#pragma unroll
                for (int bj = 0; bj < 2; ++bj) {
                    const pf4 v0 = acc[ai][bj][m][0], v1 = acc[ai][bj][m][1];
                    pu4 w; w.x = cvtpk(sigmoidf_(v0[0]), sigmoidf_(v0[1])); w.y = cvtpk(sigmoidf_(v0[2]), sigmoidf_(v0[3]));
                    w.z = cvtpk(sigmoidf_(v1[0]), sigmoidf_(v1[1])); w.w = cvtpk(sigmoidf_(v1[2]), sigmoidf_(v1[3]));
                    *(pu4*)(rowp + bj * 128) = w;
                }
            }
    }
};
template <bool ADD> struct EpiGateMul {
    static constexpr bool PERM = true, AFTER_DRAIN = false;
    const bf16* G; bf16* O;
    __device__ __forceinline__ void operator()(const pf4 (&acc)[2][2][4][2], const pg8::Unit& u, int wr, int wc, int fr, int fq) const {
        const int row0 = u.pm * 256 + wr * 64 + fr, col = u.pn * 256 + wc * 32 + 8 * fq;
#pragma unroll
        for (int ai = 0; ai < 2; ++ai)
#pragma unroll
            for (int m = 0; m < 4; ++m) {
                const size_t ro = (size_t)(row0 + ai * 128 + m * 16) * DM + col;
#pragma unroll
                for (int bj = 0; bj < 2; ++bj) {
                    const pu4 g = *(const pu4*)(G + ro + bj * 128);
                    pu4 o = (pu4){0u, 0u, 0u, 0u}; if (ADD) o = *(const pu4*)(O + ro + bj * 128);
                    const pf4 v0 = acc[ai][bj][m][0], v1 = acc[ai][bj][m][1];
                    float r[8];
#pragma unroll
                    for (int j = 0; j < 4; ++j) {
                        const unsigned gw = g[j], ow = o[j];
                        const float a0 = j < 2 ? v0[2 * j] : v1[2 * j - 4], a1 = j < 2 ? v0[2 * j + 1] : v1[2 * j - 3];
                        r[2 * j] = __builtin_bit_cast(float, gw << 16) * a0 + (ADD ? __builtin_bit_cast(float, ow << 16) : 0.f);
                        r[2 * j + 1] = __builtin_bit_cast(float, gw & 0xffff0000u) * a1 + (ADD ? __builtin_bit_cast(float, ow & 0xffff0000u) : 0.f);
                    }
                    pu4 w; w.x = cvtpk(r[0], r[1]); w.y = cvtpk(r[2], r[3]); w.z = cvtpk(r[4], r[5]); w.w = cvtpk(r[6], r[7]);
                    *(pu4*)(O + ro + bj * 128) = w;
                }
            }
    }
};

__device__ __forceinline__ void tr_item(const float* W, int ldw, int ncols, bf16* dst, int Kdst, int dst_row0, int k0, int n0, LAS float* scr, int lane) {
    const int col = lane & 31; const bool cv = (n0 + col) < ncols;
#pragma unroll 8
    for (int i = 0; i < 32; ++i) { const int kk = 2 * i + (lane >> 5); scr[kk * 33 + col] = cv ? W[(size_t)(k0 + kk) * ldw + n0 + col] : 0.f; }
    LDS_WAIT(); asm volatile("" ::: "memory");
    const int c = lane & 7;
#pragma unroll
    for (int j = 0; j < 4; ++j) { const int n = (lane >> 3) + 8 * j; const LAS float* s = scr + (8 * c) * 33 + n;
        v4u o; o.x = pk2(s[0 * 33], s[1 * 33]); o.y = pk2(s[2 * 33], s[3 * 33]); o.z = pk2(s[4 * 33], s[5 * 33]); o.w = pk2(s[6 * 33], s[7 * 33]);
        if (n0 + n < ncols) *(GAS v4u*)(dst + (size_t)(dst_row0 + n) * Kdst + k0 + 8 * c) = o; }
    LDS_WAIT(); asm volatile("" ::: "memory");
}
__device__ __forceinline__ void conv_ffn_item(const float* wg, const float* wu, const float* wd, unsigned char* ws, int r, LAS float* scr, int lane) {
    constexpr int IG = (DM / 64) * (DFF / 32);
    if (r < 2 * IG) { const bool up = r >= IG; const int rr = up ? r - IG : r; const int kb = rr / (DFF / 32), nb = rr % (DFF / 32), n0 = nb * 32;
        tr_item(up ? wu : wg, DFF, DFF, (bf16*)(ws + WS_WGU), DM, 256 * (n0 >> 7) + (up ? 128 : 0) + (n0 & 127), kb * 64, n0, scr, lane); }
    else { const int rr = r - 2 * IG; const int kb = rr / (DM / 32), nb = rr % (DM / 32);
        tr_item(wd, DM, DM, (bf16*)(ws + WS_WD), DFF, nb * 32, kb * 64, nb * 32, scr, lane); }
}
constexpr int N_FFN_ITEMS = 3 * (DM / 64) * (DFF / 32);
constexpr int I_WA = 32 * 259, I_WB = 32 * 128, I_SQ = 32 * 64, I_RG = 128;
constexpr int N_MIX_ITEMS = I_WA + I_WB + 3 * I_SQ + 2 * I_RG;
__device__ __forceinline__ void conv_mix_item(const float* const* in, unsigned char* ws, int r, LAS float* scr, int lane) {
    if (r < I_WA) { const int kb = r / 259, nb = r % 259; tr_item(in[6], NIN, NA_VALID, (bf16*)(ws + WS_WA), DM, nb * 32, kb * 64, nb * 32, scr, lane); return; } r -= I_WA;
    if (r < I_WB) { const int kb = r / 128, nb = r % 128; tr_item(in[6] + NA_VALID, NIN, NB, (bf16*)(ws + WS_WB), DM, nb * 32, kb * 64, nb * 32, scr, lane); return; } r -= I_WB;
    if (r < 3 * I_SQ) { const int w = r / I_SQ, rr = r % I_SQ, kb = rr / 64, nb = rr % 64;
        const float* src = w == 0 ? in[15] : (w == 1 ? in[16] : in[17]); const size_t off = w == 0 ? WS_WPR : (w == 1 ? WS_WPA : WS_WOUT);
        tr_item(src, DM, DM, (bf16*)(ws + off), DM, nb * 32, kb * 64, nb * 32, scr, lane); return; } r -= 3 * I_SQ;
    { const int w = r / I_RG, rr = r % I_RG, mat = rr / 8, q = rr % 8, kb = q / 4, nb = q % 4;
      tr_item((w ? in[11] : in[9]) + mat * 16384, 128, 128, (bf16*)(ws + (w ? WS_RGX : WS_RGA)) + mat * 16384, 128, nb * 32, kb * 64, nb * 32, scr, lane); }
}
template <bool TO_F32>
__device__ __forceinline__ void rms_rows(const float* x, const float* g, void* outp, int gw, int NGW, int lane) {
    f32x4 gv[8];
#pragma unroll
    for (int j = 0; j < 8; ++j) gv[j] = ((const f32x4*)g)[lane + 64 * j];
    for (int m = gw; m < MTOK; m += NGW) {
        const f32x4* xr = (const f32x4*)(x + (size_t)m * DM) + lane;
        f32x4 v[8]; float s = 0.f;
#pragma unroll
        for (int j = 0; j < 8; ++j) { v[j] = xr[64 * j]; s += (v[j].x * v[j].x + v[j].y * v[j].y) + (v[j].z * v[j].z + v[j].w * v[j].w); }
        const float rstd = 1.0f / sqrtf(wave_sum(s) * (1.0f / DM) + RMS_EPS);
        if (TO_F32) { f32x4* o = (f32x4*)((float*)outp + (size_t)m * DM) + lane;
#pragma unroll
            for (int j = 0; j < 8; ++j) o[64 * j] = v[j] * rstd * gv[j]; }
        else { unsigned long long* o8 = (unsigned long long*)((bf16*)outp + (size_t)m * DM) + lane;
#pragma unroll
            for (int j = 0; j < 8; ++j) { const f32x4 y = v[j] * rstd * gv[j]; o8[64 * j] = (unsigned long long)cvtpk(y.x, y.y) | ((unsigned long long)cvtpk(y.z, y.w) << 32); } }
    }
}

constexpr int RN_XCB = 0, RN_XCB_PITCH = 272;
constexpr int RN_XCF = 17408;
constexpr int RN_PRE = RN_XCF + 16384;
constexpr int RN_PART = RN_PRE + 32768;
constexpr int RN_CARRY = RN_PART + 4096;
__device__ __forceinline__ void rnn_unit(const float* const* in, unsigned char* ws, LAS unsigned char* lds, int unit, int tid) {
    const int lane = tid & 63, wave = __builtin_amdgcn_readfirstlane(tid >> 6);
    const int b = unit >> 5, n = (unit >> 1) & 15, hf = unit & 1;
    const bf16* RX = (const bf16*)(ws + WS_RX); bf16* RG = (bf16*)(ws + WS_RG);
    const int cc = tid & 127, tq = tid >> 7, chc = 128 * n + cc;
    const float cw0 = in[7][chc], cw1 = in[7][DM + chc], cw2 = in[7][2 * DM + chc], cw3 = in[7][3 * DM + chc], cb = in[8][chc];
    const int chs = 128 * n + 64 * hf + lane;
    const float ba = in[10][chs], bx = in[12][chs];
    const float lam = in[13][chs];
    const float c8 = -8.0f * log1pf(expf(-lam));
    const int g = wave >> 2, ct = wave & 3, fr = lane & 15, fq = lane >> 4;
    bf16x8 Bf[4];
    { const bf16* wt = (const bf16*)(ws + (g ? WS_RGX : WS_RGA)) + (size_t)n * 16384 + (size_t)(64 * hf + 16 * ct + fr) * 128 + 8 * fq;
#pragma unroll
      for (int ks = 0; ks < 4; ++ks) Bf[ks] = *(const bf16x8*)(wt + 32 * ks); }
    LAS float* xcf = (LAS float*)(lds + RN_XCF); LAS float* pre = (LAS float*)(lds + RN_PRE); LAS float* part = (LAS float*)(lds + RN_PART); LAS float* carry = (LAS float*)(lds + RN_CARRY);
    if (tid < 64) carry[tid] = 0.f;
    for (int ck = 0; ck < SEQ / 64; ++ck) {
        const int t0 = ck * 64;
        {
            float v[19];
            const int tb = t0 + 16 * tq - 3;
#pragma unroll
            for (int i = 0; i < 19; ++i) { const int tt = tb + i; v[i] = tt >= 0 ? bf2f(RX[(size_t)(b * SEQ + tt) * DM + chc]) : 0.f; }
#pragma unroll
            for (int i = 0; i < 16; ++i) {
                const float xc = cb + cw0 * v[i] + cw1 * v[i + 1] + cw2 * v[i + 2] + cw3 * v[i + 3];
                const int t = 16 * tq + i;
                *(LAS unsigned short*)(lds + RN_XCB + t * RN_XCB_PITCH + cc * 2) = (unsigned short)f2bf(xc);
                if ((cc >> 6) == hf) xcf[t * 64 + (cc & 63)] = xc;
            }
        }
        unsigned short gl[8];
#pragma unroll
        for (int i = 0; i < 8; ++i) gl[i] = RG[(size_t)(b * SEQ + t0 + 8 * wave + i) * DM + chs];
        __syncthreads();
#pragma unroll
        for (int rt = 0; rt < 4; ++rt) {
            pg8::f32x4 acc = (pg8::f32x4){0.f, 0.f, 0.f, 0.f};
#pragma unroll
            for (int ks = 0; ks < 4; ++ks) {
                const bf16x8 a = *(const LAS bf16x8*)(lds + RN_XCB + (16 * rt + fr) * RN_XCB_PITCH + (32 * ks + 8 * fq) * 2);
                acc = __builtin_amdgcn_mfma_f32_16x16x32_bf16(a, Bf[ks], acc, 0, 0, 0);
            }
#pragma unroll
            for (int i = 0; i < 4; ++i) pre[(g * 64 + 16 * rt + 4 * fq + i) * 64 + 16 * ct + fr] = acc[i];
        }
        __syncthreads();
        float av[8], uv[8]; float Aloc = 1.f, Hloc = 0.f;
#pragma unroll
        for (int i = 0; i < 8; ++i) {
            const int t = 8 * wave + i;
            const float r = sigmoidf_(pre[t * 64 + lane] + ba), ig = sigmoidf_(pre[(64 + t) * 64 + lane] + bx);
            const float la = c8 * r, a = expf(la), mult = sqrtf(-expm1f(2.0f * la));
            const float uu = mult * (ig * xcf[t * 64 + lane]);
            av[i] = a; uv[i] = uu; Hloc = a * Hloc + uu; Aloc *= a;
        }
        part[(wave * 64 + lane) * 2] = Aloc; part[(wave * 64 + lane) * 2 + 1] = Hloc;
        __syncthreads();
        float h = carry[(ck & 1) * 64 + lane];
        for (int s = 0; s < wave; ++s) h = part[(s * 64 + lane) * 2] * h + part[(s * 64 + lane) * 2 + 1];
#pragma unroll
        for (int i = 0; i < 8; ++i) {
            h = av[i] * h + uv[i];
            RG[(size_t)(b * SEQ + t0 + 8 * wave + i) * DM + chs] = (bf16)f2bf(h * bf2f(gl[i]));
        }
        if (wave == 7) carry[((ck + 1) & 1) * 64 + lane] = h;
    }
    __syncthreads();
}

__device__ __forceinline__ void idx_block(unsigned char* ws, LAS unsigned char* lds, int b, int qb, int tid) {
    const int lane = tid & 63, wave = __builtin_amdgcn_readfirstlane(tid >> 6), r32 = lane & 31, h = lane >> 5;
    const bf16* IQ = (const bf16*)(ws + WS_IQ); const bf16* IK = (const bf16*)(ws + WS_IK); const float* IW = (const float*)(ws + WS_IW);
    unsigned* MASK = (unsigned*)(ws + WS_MASK);
    const int qa = 16 * qb + 2 * wave;
    const int qpos = qa + h;
    bf16x8 af[4];
    { const int qm = qa + ((r32 >> 2) & 1), hd = (r32 & 3) + 4 * (r32 >> 3);
      const bf16* p = IQ + (size_t)(b * SEQ + qm) * IQW + hd * 64 + 8 * h;
#pragma unroll
      for (int kk = 0; kk < 4; ++kk) af[kk] = *(const bf16x8*)(p + 16 * kk); }
    float wv[16];
    { const f32x4* p = (const f32x4*)(IW + (size_t)(b * SEQ + qpos) * 16);
#pragma unroll
      for (int j = 0; j < 4; ++j) { const f32x4 t = p[j]; wv[4 * j] = t.x; wv[4 * j + 1] = t.y; wv[4 * j + 2] = t.z; wv[4 * j + 3] = t.w; } }
    LAS float* sl = (LAS float*)(lds + wave * 16384 + h * 8192) + r32;
    const int kbmax = (16 * qb + 15) >> 5;
    const float NEG = -__builtin_inff();
    for (int kb = 0; kb <= kbmax; ++kb) {
        const bf16* p = IK + (size_t)(b * SEQ + 32 * kb + r32) * 64 + 8 * h;
        f32x16 acc;
#pragma unroll
        for (int r = 0; r < 16; ++r) acc[r] = 0.f;
#pragma unroll
        for (int kk = 0; kk < 4; ++kk) { const bf16x8 bfr = *(const bf16x8*)(p + 16 * kk); acc = __builtin_amdgcn_mfma_f32_32x32x16_bf16(af[kk], bfr, acc, 0, 0, 0); }
        float s = 0.f;
#pragma unroll
        for (int r = 0; r < 16; ++r) s += wv[r] * fmaxf(acc[r], 0.f);
        sl[kb * 32] = (32 * kb + r32 <= qpos) ? s : NEG;
    }
    for (int kb = kbmax + 1; kb < 64; ++kb) sl[kb * 32] = NEG;
    LDS_WAIT(); asm volatile("" ::: "memory");
    unsigned uk[64];
#pragma unroll
    for (int j = 0; j < 64; ++j) { int i = __builtin_bit_cast(int, sl[j * 32]); i = i < 0 ? (i ^ 0x7fffffff) : i; uk[j] = (unsigned)i ^ 0x80000000u; }
    unsigned T = 0u; bool done = (qpos + 1 <= 256);
    for (int bit = 31; bit >= 0; --bit) {
        if (__all(done)) break;
        const unsigned cand = T | (1u << bit);
        int cnt = 0;
#pragma unroll
        for (int j = 0; j < 64; ++j) cnt += (uk[j] >= cand) ? 1 : 0;
#pragma unroll
        for (int o = 1; o < 32; o <<= 1) cnt += __shfl_xor(cnt, o);
        if (!done) { if (cnt >= 256) T = cand; if (cnt == 256) done = true; }
    }
    if (T < 0x00800000u) T = 0x00800000u;
    unsigned long long myw = 0ull;
#pragma unroll
    for (int j = 0; j < 64; ++j) { const unsigned long long bal = __ballot(uk[j] >= T); if (lane == j) myw = bal; }
    MASK[(size_t)(b * SEQ + qa) * 64 + lane] = (unsigned)myw;
    MASK[(size_t)(b * SEQ + qa + 1) * 64 + lane] = (unsigned)(myw >> 32);
    LDS_WAIT(); asm volatile("" ::: "memory");
}

constexpr int AT_KT = 64 * 256, AT_VP = 136, AT_VT = 128 * AT_VP, AT_BUF = AT_KT + AT_VT;
constexpr int AT_TBL = 2 * AT_BUF;
#define KSWZ(row, colB) ((row) * 256 + ((colB) ^ (((row) & 7) << 4)))
__device__ __forceinline__ int t5_bucket(int n) {
    if (n < 16) return n;
    const int th[16] = {19, 21, 24, 27, 31, 35, 40, 46, 52, 59, 67, 77, 87, 99, 113, 1 << 30};
    int bkt = 16;
#pragma unroll
    for (int i = 0; i < 15; ++i) bkt += (n >= th[i]) ? 1 : 0;
    return bkt;
}
__device__ __forceinline__ void attn_tile(unsigned char* ws, LAS unsigned char* lds, int b, int kvh, int t, int tid) {
    const int lane = tid & 63, wave = __builtin_amdgcn_readfirstlane(tid >> 6), r32 = lane & 31, h = lane >> 5;
    const int g = wave >> 1, qs = wave & 1, hq = kvh * 4 + g;
    const int q = 64 * t + 32 * qs + r32;
    bf16* Qg = (bf16*)(ws + WS_Q) + (size_t)(b * SEQ + q) * DM + hq * 128;
    const bf16* Kg = (const bf16*)(ws + WS_K) + (size_t)(b * SEQ) * KVW + kvh * 128;
    const bf16* Vg = (const bf16*)(ws + WS_VT) + (size_t)((b * 4 + kvh) * 128) * SEQ;
    const unsigned* Mg = (const unsigned*)(ws + WS_MASK) + (size_t)(b * SEQ + q) * 64;
    const LAS float* tbl = (const LAS float*)(lds + AT_TBL) + g * 132;
    bf16x8 qr[8];
#pragma unroll
    for (int d0 = 0; d0 < 8; ++d0) qr[d0] = *(const bf16x8*)(Qg + d0 * 16 + h * 8);
    const int sr = tid >> 4, sc = (tid & 15) * 8;
    const int vd = tid >> 3, vp = tid & 7;
    const int kws = KSWZ(sr, sc * 2);
    v4u sk0, sk1, sv0, sv1; v2u mw;
#define AT_LOAD(kt) do { const bf16* kp = Kg + (size_t)(64 * (kt) + sr) * KVW + sc; sk0 = *(const v4u*)kp; sk1 = *(const v4u*)(kp + 32 * KVW); \
        const bf16* vq = Vg + (size_t)vd * SEQ + 64 * (kt) + vp * 8; sv0 = *(const v4u*)vq; sv1 = *(const v4u*)(vq + 64 * SEQ); } while (0)
#define AT_WRITE(bufo) do { LAS unsigned char* kb_ = lds + (bufo); *(LAS v4u*)(kb_ + kws) = sk0; *(LAS v4u*)(kb_ + kws + 32 * 256) = sk1; \
        LAS unsigned char* vb_ = kb_ + AT_KT + vd * AT_VP + vp * 16; *(LAS v2u*)vb_ = (v2u){sv0.x, sv0.y}; *(LAS v2u*)(vb_ + 8) = (v2u){sv0.z, sv0.w}; \
        *(LAS v2u*)(vb_ + 64 * AT_VP) = (v2u){sv1.x, sv1.y}; *(LAS v2u*)(vb_ + 64 * AT_VP + 8) = (v2u){sv1.z, sv1.w}; } while (0)
    AT_LOAD(0); AT_WRITE(0);
    v2u mwn = *(const v2u*)(Mg);
    __syncthreads();
    f32x16 o[4];
#pragma unroll
    for (int d = 0; d < 4; ++d)
#pragma unroll
        for (int r = 0; r < 16; ++r) o[d][r] = 0.f;
    float m_run = -1e30f, l_run = 0.f;
    const float C2 = 0.08838834764831845f * LOG2E;
    const float bfar = tbl[128];
    for (int kt = 0; kt <= t; ++kt) {
        const int bufo = (kt & 1) * AT_BUF;
        mw = mwn;
        if (kt < t) { AT_LOAD(kt + 1); mwn = *(const v2u*)(Mg + 2 * (kt + 1)); }
        f32x16 p0, p1;
#pragma unroll
        for (int r = 0; r < 16; ++r) { p0[r] = 0.f; p1[r] = 0.f; }
#pragma unroll
        for (int d0 = 0; d0 < 8; ++d0) {
            const LAS unsigned char* a = lds + bufo + KSWZ(r32, (d0 * 16 + h * 8) * 2);
            const bf16x8 a0 = *(const LAS bf16x8*)a, a1 = *(const LAS bf16x8*)(a + 32 * 256);
            p0 = __builtin_amdgcn_mfma_f32_32x32x16_bf16(a0, qr[d0], p0, 0, 0, 0);
            p1 = __builtin_amdgcn_mfma_f32_32x32x16_bf16(a1, qr[d0], p1, 0, 0, 0);
        }
        if (kt + 3 > t) {
            const int D0 = q - 64 * kt - 4 * h;
#pragma unroll
            for (int r = 0; r < 16; ++r) {
                const int c = (r & 3) + 8 * (r >> 2);
                unsigned i0 = (unsigned)(D0 - c), i1 = (unsigned)(D0 - 32 - c);
                i0 = i0 > 128u ? 128u : i0; i1 = i1 > 128u ? 128u : i1;
                p0[r] = p0[r] * C2 + tbl[i0]; p1[r] = p1[r] * C2 + tbl[i1];
            }
        } else {
#pragma unroll
            for (int r = 0; r < 16; ++r) { p0[r] = p0[r] * C2 + bfar; p1[r] = p1[r] * C2 + bfar; }
        }
        float mx = p0[0];
#pragma unroll
        for (int r = 1; r < 16; ++r) mx = fmaxf(mx, p0[r]);
#pragma unroll
        for (int r = 0; r < 16; ++r) mx = fmaxf(mx, p1[r]);
        mx = fmaxf(mx, __shfl_xor(mx, 32));
        if (!__all(mx <= m_run + 8.0f)) {
            const float mn = fmaxf(m_run, mx), alpha = fast_exp2(m_run - mn);
            m_run = mn; l_run *= alpha;
#pragma unroll
            for (int d = 0; d < 4; ++d)
#pragma unroll
                for (int r = 0; r < 16; ++r) o[d][r] *= alpha;
        }
        const int wl = (int)(mw.x >> (4 * h)), wh = (int)(mw.y >> (4 * h));
        float ps = 0.f;
#pragma unroll
        for (int r = 0; r < 16; ++r) {
            const int c = (r & 3) + 8 * (r >> 2);
            const unsigned e0 = __builtin_bit_cast(unsigned, fast_exp2(p0[r] - m_run)) & (unsigned)__builtin_amdgcn_sbfe(wl, c, 1);
            const unsigned e1 = __builtin_bit_cast(unsigned, fast_exp2(p1[r] - m_run)) & (unsigned)__builtin_amdgcn_sbfe(wh, c, 1);
            p0[r] = __builtin_bit_cast(float, e0); p1[r] = __builtin_bit_cast(float, e1);
            ps += p0[r] + p1[r];
        }
        l_run += ps;
        bf16x8 pk[4];
        { v4u w0 = {cvtpk(p0[0], p0[1]), cvtpk(p0[2], p0[3]), cvtpk(p0[4], p0[5]), cvtpk(p0[6], p0[7])}; pk[0] = __builtin_bit_cast(bf16x8, w0);
          v4u w1 = {cvtpk(p0[8], p0[9]), cvtpk(p0[10], p0[11]), cvtpk(p0[12], p0[13]), cvtpk(p0[14], p0[15])}; pk[1] = __builtin_bit_cast(bf16x8, w1);
          v4u w2 = {cvtpk(p1[0], p1[1]), cvtpk(p1[2], p1[3]), cvtpk(p1[4], p1[5]), cvtpk(p1[6], p1[7])}; pk[2] = __builtin_bit_cast(bf16x8, w2);
          v4u w3 = {cvtpk(p1[8], p1[9]), cvtpk(p1[10], p1[11]), cvtpk(p1[12], p1[13]), cvtpk(p1[14], p1[15])}; pk[3] = __builtin_bit_cast(bf16x8, w3); }
#pragma unroll
        for (int d0 = 0; d0 < 4; ++d0) {
            const LAS unsigned char* vb = lds + bufo + AT_KT + (32 * d0 + r32) * AT_VP + 8 * h;
#pragma unroll
            for (int ks = 0; ks < 4; ++ks) {
                const v2u lo = *(const LAS v2u*)(vb + 32 * ks), hi = *(const LAS v2u*)(vb + 32 * ks + 16);
                const v4u av = {lo.x, lo.y, hi.x, hi.y};
                o[d0] = __builtin_amdgcn_mfma_f32_32x32x16_bf16(__builtin_bit_cast(bf16x8, av), pk[ks], o[d0], 0, 0, 0);
            }
        }
        if (kt < t) AT_WRITE(((kt + 1) & 1) * AT_BUF);
        __syncthreads();
    }
    const float lt = l_run + __shfl_xor(l_run, 32), rl = 1.0f / lt;
#pragma unroll
    for (int d0 = 0; d0 < 4; ++d0)
#pragma unroll
        for (int gq = 0; gq < 4; ++gq) {
            const v2u w = {cvtpk(o[d0][4 * gq] * rl, o[d0][4 * gq + 1] * rl), cvtpk(o[d0][4 * gq + 2] * rl, o[d0][4 * gq + 3] * rl)};
            *(v2u*)(Qg + 32 * d0 + 8 * gq + 4 * h) = w;
        }
#undef AT_LOAD
#undef AT_WRITE
}
__device__ __forceinline__ void attn_unit(const float* rel_bias, unsigned char* ws, LAS unsigned char* lds, int unit, int tid) {
    const int b = unit >> 6, kvh = (unit >> 4) & 3, p = unit & 15;
    __syncthreads();
    for (int i = tid; i < 4 * 132; i += NTHR) { const int g = i / 132, d = i % 132;
        ((LAS float*)(lds + AT_TBL))[i] = rel_bias[(d >= 128 ? 31 : t5_bucket(d)) * 16 + kvh * 4 + g] * LOG2E; }
    __syncthreads();
    attn_tile(ws, lds, b, kvh, p, tid);
    attn_tile(ws, lds, b, kvh, 31 - p, tid);
}

#ifndef MK_N_LAUNCHES
#define MK_N_LAUNCHES 1
#endif
constexpr int N_PHASES = 15;
struct Args { const float* in[23]; float* out; unsigned char* ws; int ph_lo, ph_hi; };
static_assert(sizeof(Args) == 23 * 8 + 8 + 8 + 8, "Args has no padding");

__global__ void __launch_bounds__(NTHR, 2) mk_fwd(Args args) {
    extern __shared__ __attribute__((aligned(16))) unsigned char lds_raw[];
    LAS unsigned char* lds = (LAS unsigned char*)lds_raw;
    volatile LAS unsigned* MISC = (volatile LAS unsigned*)(lds + MISC_OFF);
    const int tid = threadIdx.x, lane = tid & 63, wave = __builtin_amdgcn_readfirstlane(tid >> 6);
    const int G = gridDim.x;
    unsigned char* ws = args.ws;
    gu32* ctl = (gu32*)(ws + WS_CTL);
#ifdef PROBE_CLEAR
    for (int u = tid; u < LDS_BYTES / 4; u += NTHR) ((LAS unsigned*)lds)[u] = 0u;
#else
    for (int u = tid; u < (LDS_BYTES - LDSCTL_OFF) / 4; u += NTHR) ((LAS unsigned*)(lds + LDSCTL_OFF))[u] = 0u;
#endif
    __syncthreads();
    XcdBarrier bar; bar.bar = (unsigned*)(ctl + CW_BAR); bar.x = 0; bar.st = nullptr;
    const int lo = args.ph_lo, hi = args.ph_hi;
    if (hi - lo > 1) bar = xcd_barrier_post((unsigned*)(ctl + CW_BAR), MISC + 8);
#define IN(k) (lo <= (k) && (k) < hi)
#define BOTH(k) (IN(k) && IN((k) + 1))
#define GRID_BAR(k) do { if (BOTH(k)) xcd_barrier(bar); } while (0)
    const int gw = blockIdx.x * NWAVES + wave, NGW = G * NWAVES;
    LAS float* scr = (LAS float*)(lds + RING_OFF + wave * 16384);
    bf16* Hb = (bf16*)(ws + WS_H);

    if (IN(0)) {
        for (int it = gw; it < N_FFN_ITEMS; it += NGW) conv_ffn_item(args.in[2], args.in[3], args.in[4], ws, it, scr, lane);
        for (int it = gw; it < N_MIX_ITEMS; it += NGW) conv_mix_item(args.in, ws, it, scr, lane);
        { v4u* z = (v4u*)((bf16*)(ws + WS_WA) + (size_t)NA_VALID * DM); const int nz = (NA - NA_VALID) * DM * 2 / 16;
          for (int i = blockIdx.x * NTHR + tid; i < nz; i += G * NTHR) z[i] = (v4u){0u, 0u, 0u, 0u}; }
        rms_rows<false>(args.in[0], args.in[1], Hb, gw, NGW, lane);
        GRID_BAR(0);
    }
    if (IN(1)) {
        pg8::Gemm g{Hb, (const bf16*)(ws + WS_WGU), MTOK, NGU, DM}; pg8::StaticOrder S; S.init(MTOK, NGU, G, (int)blockIdx.x);
        EpiSwiGLU E{(bf16*)(ws + WS_ACT)};
        pg8::gemm_phase<EpiSwiGLU, pg8::StaticOrder, true, true>(lds + RING_OFF, g, S, E);
        GRID_BAR(1);
    }
    if (IN(2)) {
        pg8::Gemm g{(const bf16*)(ws + WS_ACT), (const bf16*)(ws + WS_WD), MTOK, DM, DFF}; pg8::StaticOrder S; S.init(MTOK, DM, G, (int)blockIdx.x);
        EpiResid E{args.in[0], args.out, 0.5f};
        pg8::gemm_phase<EpiResid, pg8::StaticOrder, true, true>(lds + RING_OFF, g, S, E);
        GRID_BAR(2);
    }
    if (IN(3)) {
        rms_rows<false>(args.out, args.in[5], Hb, gw, NGW, lane);
        for (int it = gw; it < N_FFN_ITEMS; it += NGW) conv_ffn_item(args.in[19], args.in[20], args.in[21], ws, it, scr, lane);
        GRID_BAR(3);
    }
    if (IN(4)) {
        pg8::Gemm g{Hb, (const bf16*)(ws + WS_WA), MTOK, NA, DM}; pg8::StaticOrder S; S.init(MTOK, NA, G, (int)blockIdx.x);
        EpiProjA E{ws};
        pg8::gemm_phase<EpiProjA, pg8::StaticOrder, true, true>(lds + RING_OFF, g, S, E);
        GRID_BAR(4);
    }
    if (IN(5)) {
        for (int u = blockIdx.x; u < 256; u += G) rnn_unit(args.in, ws, lds, u, tid);
        for (int j = blockIdx.x; j < 512; j += G) { const int b = j >> 6, p = j & 63; idx_block(ws, lds, b, p, tid); idx_block(ws, lds, b, 127 - p, tid); }
        GRID_BAR(5);
    }
    if (IN(6)) {
        for (int u = blockIdx.x; u < 512; u += G) attn_unit(args.in[14], ws, lds, u, tid);
        GRID_BAR(6);
    }
    if (IN(7)) {
        pg8::Gemm g{Hb, (const bf16*)(ws + WS_WB), MTOK, NB, DM}; pg8::StaticOrder S; S.init(MTOK, NB, G, (int)blockIdx.x);
        EpiGates E{ws};
        pg8::gemm_phase<EpiGates, pg8::StaticOrder, true, true>(lds + RING_OFF, g, S, E);
        GRID_BAR(7);
    }
    if (IN(8)) {
        pg8::Gemm g{(const bf16*)(ws + WS_RG), (const bf16*)(ws + WS_WPR), MTOK, DM, DM}; pg8::StaticOrder S; S.init(MTOK, DM, G, (int)blockIdx.x);
        EpiGateMul<false> E{(const bf16*)(ws + WS_RX), (bf16*)(ws + WS_RX)};
        pg8::gemm_phase<EpiGateMul<false>, pg8::StaticOrder, true, true>(lds + RING_OFF, g, S, E);
        GRID_BAR(8);
    }
    if (IN(9)) {
        pg8::Gemm g{(const bf16*)(ws + WS_Q), (const bf16*)(ws + WS_WPA), MTOK, DM, DM}; pg8::StaticOrder S; S.init(MTOK, DM, G, (int)blockIdx.x);
        EpiGateMul<true> E{(const bf16*)(ws + WS_SGA), (bf16*)(ws + WS_RX)};
        pg8::gemm_phase<EpiGateMul<true>, pg8::StaticOrder, true, true>(lds + RING_OFF, g, S, E);
        GRID_BAR(9);
    }
    if (IN(10)) {
        pg8::Gemm g{(const bf16*)(ws + WS_RX), (const bf16*)(ws + WS_WOUT), MTOK, DM, DM}; pg8::StaticOrder S; S.init(MTOK, DM, G, (int)blockIdx.x);
        EpiResid E{args.out, args.out, 1.0f};
        pg8::gemm_phase<EpiResid, pg8::StaticOrder, true, true>(lds + RING_OFF, g, S, E);
        GRID_BAR(10);
    }
    if (IN(11)) {
        rms_rows<false>(args.out, args.in[18], Hb, gw, NGW, lane);
        GRID_BAR(11);
    }
    if (IN(12)) {
        pg8::Gemm g{Hb, (const bf16*)(ws + WS_WGU), MTOK, NGU, DM}; pg8::StaticOrder S; S.init(MTOK, NGU, G, (int)blockIdx.x);
        EpiSwiGLU E{(bf16*)(ws + WS_ACT)};
        pg8::gemm_phase<EpiSwiGLU, pg8::StaticOrder, true, true>(lds + RING_OFF, g, S, E);
        GRID_BAR(12);
    }
    if (IN(13)) {
        pg8::Gemm g{(const bf16*)(ws + WS_ACT), (const bf16*)(ws + WS_WD), MTOK, DM, DFF}; pg8::StaticOrder S; S.init(MTOK, DM, G, (int)blockIdx.x);
        EpiResid E{args.out, args.out, 0.5f};
        pg8::gemm_phase<EpiResid, pg8::StaticOrder, true, true>(lds + RING_OFF, g, S, E);
        GRID_BAR(13);
    }
    if (IN(14)) {
        rms_rows<true>(args.out, args.in[22], args.out, gw, NGW, lane);
    }
#undef IN
#undef BOTH
#undef GRID_BAR
}


#if defined(PROBE_DIGEST) || defined(PROBE_P7)
__global__ void final3_k(const unsigned long long* D, float* out, size_t n) {
    const float c = (float)((D[0] != D[1] ? 1 : 0) + (D[1] != D[2] ? 2 : 0));
    for (size_t i = (size_t)blockIdx.x * blockDim.x + threadIdx.x; i < n; i += (size_t)gridDim.x * blockDim.x) out[i] = c;
}
__global__ void digest_k(const v4u* p, size_t n16, const v4u* q, size_t m16, unsigned long long* slot) {
    unsigned long long s = 0ull;
    for (size_t i = (size_t)blockIdx.x * blockDim.x + threadIdx.x; i < n16 + m16; i += (size_t)gridDim.x * blockDim.x) {
        const v4u x = i < n16 ? p[i] : q[i - n16];
        const unsigned long long h = (unsigned long long)i * 0x9E3779B97F4A7C15ull + 0x1234567ull;
        s += ((unsigned long long)x.x * 3ull + (unsigned long long)x.y * 5ull + (unsigned long long)x.z * 7ull + (unsigned long long)x.w * 11ull) * (h | 1ull);
    }
    for (int o = 32; o >= 1; o >>= 1) s += __shfl_xor(s, o);
    if ((threadIdx.x & 63) == 0) atomicAdd(slot, s);
}
__global__ void final_k(const unsigned long long* A, const unsigned long long* B, float* out, size_t n) {
    int k = 0; for (int i = N_PHASES - 1; i >= 0; --i) if (A[i] != B[i]) k = i + 1;
    const float c = (float)k;
    for (size_t i = (size_t)blockIdx.x * blockDim.x + threadIdx.x; i < n; i += (size_t)gridDim.x * blockDim.x) out[i] = c;
}
#endif
extern "C" void kernel_launch(void* const* d_in, const int* in_sizes, int n_in, void* d_out, int out_size, void* d_ws, size_t ws_size, hipStream_t stream) {
    static int grid = 0;
    if (grid == 0) {
        if (n_in != 23 || in_sizes[0] != MTOK * DM || out_size != MTOK * DM || ws_size < WS_END) {
            fprintf(stderr, "kernel_launch: unexpected shapes (n_in %d, in0 %d, out %d, ws %zu); nothing launched\n", n_in, n_in > 0 ? in_sizes[0] : -1, out_size, ws_size); grid = -1; return; }
        int dev = 0, cus = 0, per_cu = 0;
        if (hipGetDevice(&dev) != hipSuccess || hipDeviceGetAttribute(&cus, hipDeviceAttributeMultiprocessorCount, dev) != hipSuccess) { grid = -1; return; }
        if (hipFuncSetAttribute((const void*)mk_fwd, hipFuncAttributeMaxDynamicSharedMemorySize, LDS_BYTES) != hipSuccess) { fprintf(stderr, "kernel_launch: hipFuncSetAttribute failed\n"); grid = -1; return; }
        if (hipOccupancyMaxActiveBlocksPerMultiprocessor(&per_cu, (const void*)mk_fwd, NTHR, LDS_BYTES) != hipSuccess || per_cu < 1)
            fprintf(stderr, "kernel_launch: note: occupancy query reports %d workgroups per CU\n", per_cu);
        (void)hipGetLastError();
        grid = cus;
    }
    if (grid < 0) return;
#ifdef PROBE_CLEAR
    if (hipMemsetAsync((char*)d_ws, 0, WS_END, stream) != hipSuccess) return;
    if (hipMemsetAsync((char*)d_out, 0, (size_t)MTOK * DM * 4, stream) != hipSuccess) return;
#else
    if (hipMemsetAsync((char*)d_ws + WS_CTL, 0, CTL_ZERO_BYTES, stream) != hipSuccess) return;
#endif
    Args a{};
    for (int i = 0; i < 23; ++i) a.in[i] = (const float*)d_in[i];
    a.out = (float*)d_out; a.ws = (unsigned char*)d_ws;
#ifdef PROBE_DIGEST
    unsigned long long* slots = (unsigned long long*)((char*)d_ws + WS_END);
    (void)hipMemsetAsync(slots, 0, 4096, stream);
    for (int run = 0; run < 2; ++run) {
        (void)hipMemsetAsync((char*)d_ws, 0, WS_END, stream);
        (void)hipMemsetAsync((char*)d_out, 0, (size_t)MTOK * DM * 4, stream);
        for (int k = 0; k < N_PHASES; ++k) { a.ph_lo = k; a.ph_hi = k + 1; hipLaunchKernelGGL(mk_fwd, dim3(grid), dim3(NTHR), LDS_BYTES, stream, a);
            hipLaunchKernelGGL(digest_k, dim3(2048), dim3(256), 0, stream, (const v4u*)((char*)d_ws + MiB), (size_t)(WS_END - MiB) / 16, (const v4u*)d_out, (size_t)MTOK * DM * 4 / 16, slots + run * 64 + k); }
    }
    hipLaunchKernelGGL(final_k, dim3(2048), dim3(256), 0, stream, slots, slots + 64, (float*)d_out, (size_t)MTOK * DM);
#elif defined(PROBE_P7)
    unsigned long long* slots = (unsigned long long*)((char*)d_ws + WS_END);
    (void)hipMemsetAsync(slots, 0, 4096, stream);
    (void)hipMemsetAsync((char*)d_ws, 0, WS_END, stream);
    (void)hipMemsetAsync((char*)d_out, 0, (size_t)MTOK * DM * 4, stream);
    for (int k = 0; k < 7; ++k) { a.ph_lo = k; a.ph_hi = k + 1; hipLaunchKernelGGL(mk_fwd, dim3(grid), dim3(NTHR), LDS_BYTES, stream, a); }
    for (int r = 0; r < 3; ++r) { a.ph_lo = 7; a.ph_hi = 8; hipLaunchKernelGGL(mk_fwd, dim3(grid), dim3(NTHR), LDS_BYTES, stream, a);
        hipLaunchKernelGGL(digest_k, dim3(2048), dim3(256), 0, stream, (const v4u*)((char*)d_ws + MiB), (size_t)(WS_END - MiB) / 16, (const v4u*)d_out, (size_t)MTOK * DM * 4 / 16, slots + r); }
    hipLaunchKernelGGL(final3_k, dim3(2048), dim3(256), 0, stream, slots, (float*)d_out, (size_t)MTOK * DM);
#elif MK_N_LAUNCHES == 1
    a.ph_lo = 0; a.ph_hi = N_PHASES;
    hipLaunchKernelGGL(mk_fwd, dim3(grid), dim3(NTHR), LDS_BYTES, stream, a);
#else
    for (int k = 0; k < N_PHASES; ++k) { a.ph_lo = k; a.ph_hi = k + 1; hipLaunchKernelGGL(mk_fwd, dim3(grid), dim3(NTHR), LDS_BYTES, stream, a); }
#endif
}
```

```cpp
#include <hip/hip_runtime.h>
#include <cstdio>
#include <cstdint>
#ifdef PROBE_EPI
#define PG8_HOOK_PRE() do { if (blockIdx.x == 0 && threadIdx.x == 0) { volatile __attribute__((address_space(3))) unsigned* M_ = (volatile __attribute__((address_space(3))) unsigned*)(163840 - 512 + 320); \
    if (M_[24] == PROBE_EPI) { asm volatile("s_waitcnt vmcnt(0)" ::: "memory"); M_[25] = (unsigned)__builtin_amdgcn_s_memrealtime(); } } } while (0)
#define PG8_HOOK_POST() do { if (blockIdx.x == 0 && threadIdx.x == 0) { volatile __attribute__((address_space(3))) unsigned* M_ = (volatile __attribute__((address_space(3))) unsigned*)(163840 - 512 + 320); \
    if (M_[24] == PROBE_EPI) { asm volatile("s_waitcnt vmcnt(0)" ::: "memory"); M_[22] += (unsigned)__builtin_amdgcn_s_memrealtime() - M_[25]; M_[23] += 1u; } } } while (0)
#else
#define PG8_HOOK_PRE() do { } while (0)
#define PG8_HOOK_POST() do { } while (0)
#endif
#define MK_N_LAUNCHES 1
namespace pg8 {
#define PG8_LAS __attribute__((address_space(3)))
typedef unsigned short bf16_t;
typedef short bf16x8 __attribute__((ext_vector_type(8)));
typedef float f32x4 __attribute__((ext_vector_type(4)));
typedef unsigned u32x4 __attribute__((ext_vector_type(4)));
constexpr int BM = 256, BK = 64, HALF = 128, HTB = HALF * BK * 2  , STAGE_BYTES = 8 * HTB, NXCD = 8, WGM = 8;

__host__ __device__ __forceinline__ int lds_byte(int r, int c) { const int st = (r >> 4) * 2 + (c >> 5), rr = r & 15, cc = c & 31, ob = rr * 64 + cc * 2; return st * 1024 + (ob ^ (((ob >> 9) & 1) << 5)); }
__host__ __device__ __forceinline__ void stage_rc(int b, int& R, int& C) { const int st = b / 1024, sb = b % 1024, swz = sb ^ (((sb >> 9) & 1) << 5); R = (st >> 1) * 16 + swz / 64; C = (st & 1) * 32 + (swz % 64) / 2; }
__host__ __device__ __forceinline__ int perm32(int rho) { const int n = rho >> 4, i = rho & 15; return 8 * (i >> 2) + 4 * n + (i & 3); }

struct Unit { int pm, pn; };
struct Gemm { const bf16_t* A; const bf16_t* Bt; int M, N, K; };

struct StaticOrder {
    int nM, nN, nwg, G, c;
    __host__ __device__ void init(int M, int N, int G_, int c_) { nM = M / BM; nN = N / BM; nwg = nM * nN; G = G_; c = c_; }
    __host__ __device__ bool next(int i, Unit& u) const {
        const long L = (long)i * G + c; if (L >= nwg) return false;
        int wgid = (int)L; { const int q = nwg / NXCD, r = nwg % NXCD, xcd = wgid % NXCD, off = wgid / NXCD; wgid = (xcd < r ? xcd * (q + 1) : r * (q + 1) + (xcd - r) * q) + off; }
        const int nig = WGM * nN, gid = wgid / nig, fm = gid * WGM, gsz = (nM - fm) < WGM ? (nM - fm) : WGM;
        u.pm = fm + ((wgid % nig) % gsz); u.pn = (wgid % nig) / gsz; return true;
    }
    __device__ __forceinline__ void a_ready(const Unit&) const {}
    __device__ __forceinline__ void done(const Unit&) const {}
};
__device__ __forceinline__ unsigned cvt_pk_bf16(float lo, float hi) { unsigned r; asm volatile("v_cvt_pk_bf16_f32 %0, %1, %2" : "=v"(r) : "v"(lo), "v"(hi)); return r; }
typedef float f32x2 __attribute__((ext_vector_type(2)));
template <class Epi, class Sched, bool ALIGN_EPI = false, bool SP2 = false>
__device__ __forceinline__ void gemm_phase(PG8_LAS unsigned char* lds, const Gemm g, const Sched& S, const Epi& E) {
    const int tid = threadIdx.x, wid = __builtin_amdgcn_readfirstlane(tid >> 6), lane = tid & 63, wr = wid >> 2, wc = wid & 3, fr = lane & 15, fq = lane >> 4;
    const int K = g.K, nt = K / BK;
    unsigned voffA[2], voffB[2];
#pragma unroll
    for (int i = 0; i < 2; ++i) { int R, C; stage_rc(tid * 16 + i * 8192, R, C); const int Rb = Epi::PERM ? ((R & ~31) + perm32(R & 31)) : R;
        voffA[i] = (unsigned)(R * K + C) * 2u; voffB[i] = (unsigned)(Rb * K + C) * 2u; }
    const size_t kstep = (size_t)(BK * 2);
    const size_t hstep = (size_t)HALF * K * 2;
    const size_t tstep = 2 * hstep;
    const unsigned ldsw = (unsigned)wid * 1024u;
    const int aoff = lds_byte(wr * 64 + fr, fq * 8), boff = lds_byte(wc * 32 + fr, fq * 8);
#define PG8_SA(b, h) (((b) * 2 + (h)) * HTB)
#define PG8_SB(b, h) ((4 + (b) * 2 + (h)) * HTB)
#define PG8_STAGE(bufoff, gbase, voff) do { _Pragma("unroll") for (int _i = 0; _i < 2; ++_i) \
        __builtin_amdgcn_global_load_lds((const unsigned*)((const char*)(gbase) + (voff)[_i]), (PG8_LAS unsigned*)(lds + (bufoff) + ldsw + _i * 8192), 16, 0, 0); } while (0)
#define PG8_LDA(dst, b, h) do { _Pragma("unroll") for (int m = 0; m < 4; ++m) _Pragma("unroll") for (int k = 0; k < 2; ++k) dst[m][k] = *(const PG8_LAS bf16x8*)(lds + PG8_SA(b, h) + aoff + m * 2048 + k * 1024); } while (0)
#define PG8_LDB(dst, b, h) do { _Pragma("unroll") for (int n = 0; n < 2; ++n) _Pragma("unroll") for (int k = 0; k < 2; ++k) dst[n][k] = *(const PG8_LAS bf16x8*)(lds + PG8_SB(b, h) + boff + n * 2048 + k * 1024); } while (0)
#define PG8_MMA(ai, bj, At, Bt) do { __builtin_amdgcn_s_setprio(1); _Pragma("unroll") for (int m = 0; m < 4; ++m) _Pragma("unroll") for (int n = 0; n < 2; ++n) _Pragma("unroll") for (int k = 0; k < 2; ++k) \
        acc[ai][bj][m][n] = __builtin_amdgcn_mfma_f32_16x16x32_bf16(Bt[n][k], At[m][k], acc[ai][bj][m][n], 0, 0, 0); __builtin_amdgcn_s_setprio(0); } while (0)
#define PG8_WAIT_V(n) asm volatile("s_waitcnt vmcnt(" #n ")" ::: "memory")
#define PG8_WAIT_L(n) asm volatile("s_waitcnt lgkmcnt(" #n ")" ::: "memory")
#define PG8_BAR __builtin_amdgcn_s_barrier()
#define PG8_SCHED __builtin_amdgcn_sched_barrier(0)
    Unit cur, nxt; int ui = 0;
    if (!S.next(0, cur)) return;
    f32x4 acc[2][2][4][2];
#pragma unroll
    for (int a = 0; a < 2; ++a)
#pragma unroll
        for (int b = 0; b < 2; ++b)
#pragma unroll
            for (int m = 0; m < 4; ++m)
#pragma unroll
                for (int n = 0; n < 2; ++n) acc[a][b][m][n] = (f32x4){0.f, 0.f, 0.f, 0.f};
    bf16x8 At[4][2], B0[2][2], B1[2][2];
    const char* cA = (const char*)g.A + (size_t)cur.pm * tstep; const char* cB = (const char*)g.Bt + (size_t)cur.pn * tstep;
    S.a_ready(cur);
    if constexpr (SP2) {
        PG8_STAGE(PG8_SB(0, 0), cB, voffB); PG8_STAGE(PG8_SB(0, 1), cB + hstep, voffB); PG8_STAGE(PG8_SA(0, 0), cA, voffA); PG8_STAGE(PG8_SA(0, 1), cA + hstep, voffA);
        if (wr == 1) PG8_BAR;
        PG8_WAIT_V(2); PG8_BAR;
        PG8_STAGE(PG8_SB(1, 0), cB + kstep, voffB); PG8_STAGE(PG8_SA(1, 0), cA + kstep, voffA); PG8_STAGE(PG8_SB(1, 1), cB + hstep + kstep, voffB);
        PG8_WAIT_V(6); PG8_BAR;
    } else {
        PG8_STAGE(PG8_SB(0, 0), cB, voffB); PG8_STAGE(PG8_SA(0, 0), cA, voffA); PG8_STAGE(PG8_SB(0, 1), cB + hstep, voffB); PG8_STAGE(PG8_SA(0, 1), cA + hstep, voffA);
        if (wr == 1) PG8_BAR;
        PG8_WAIT_V(4); PG8_BAR;
        PG8_STAGE(PG8_SB(1, 0), cB + kstep, voffB); PG8_STAGE(PG8_SA(1, 0), cA + kstep, voffA); PG8_STAGE(PG8_SB(1, 1), cB + hstep + kstep, voffB);
        PG8_WAIT_V(6); PG8_BAR;
    }
    for (;;) {
        const bool has_next = S.next(ui + 1, nxt);
        const char* nA = has_next ? (const char*)g.A + (size_t)nxt.pm * tstep : cA; const char* nB = has_next ? (const char*)g.Bt + (size_t)nxt.pn * tstep : cB;
        for (int t = 0; t < nt; t += 2) {
            const bool last = (t == nt - 2);
            const char* a1 = cA + (size_t)(t + 1) * kstep;
            const char* a2 = last ? nA : cA + (size_t)(t + 2) * kstep; const char* b2 = last ? nB : cB + (size_t)(t + 2) * kstep;
            const char* a3 = a2 + kstep; const char* b3 = b2 + kstep;
            if (last && has_next) S.a_ready(nxt);
            if constexpr (SP2) {
            PG8_LDB(B0, 0, 0); PG8_LDB(B1, 0, 1); PG8_SCHED; PG8_LDA(At, 0, 0); PG8_STAGE(PG8_SA(1, 1), a1 + hstep, voffA);
            PG8_WAIT_V(8); PG8_WAIT_L(0); PG8_BAR; PG8_MMA(0, 0, At, B0); PG8_MMA(0, 1, At, B1); PG8_BAR; PG8_SCHED;
            PG8_LDA(At, 0, 1); PG8_STAGE(PG8_SB(0, 0), b2, voffB); PG8_STAGE(PG8_SB(0, 1), b2 + hstep, voffB); PG8_STAGE(PG8_SA(0, 0), a2, voffA);
            PG8_WAIT_V(8); PG8_WAIT_L(0); PG8_BAR; PG8_MMA(1, 0, At, B0); PG8_MMA(1, 1, At, B1); PG8_BAR; PG8_SCHED;
            PG8_LDB(B0, 1, 0); PG8_LDB(B1, 1, 1); PG8_SCHED; PG8_LDA(At, 1, 0); PG8_STAGE(PG8_SA(0, 1), a2 + hstep, voffA);
            PG8_WAIT_V(8); PG8_WAIT_L(0); PG8_BAR; PG8_MMA(0, 0, At, B0); PG8_MMA(0, 1, At, B1); PG8_BAR; PG8_SCHED;
            PG8_LDA(At, 1, 1); PG8_STAGE(PG8_SB(1, 0), b3, voffB); PG8_STAGE(PG8_SB(1, 1), b3 + hstep, voffB); PG8_STAGE(PG8_SA(1, 0), a3, voffA);
            PG8_WAIT_V(8); PG8_WAIT_L(0); PG8_BAR; PG8_MMA(1, 0, At, B0); PG8_MMA(1, 1, At, B1); PG8_BAR; PG8_SCHED;
            } else {
            PG8_LDB(B0, 0, 0); PG8_SCHED; PG8_LDA(At, 0, 0); PG8_STAGE(PG8_SA(1, 1), a1 + hstep, voffA);
            PG8_WAIT_L(8); PG8_BAR; PG8_WAIT_L(0); PG8_MMA(0, 0, At, B0); PG8_BAR; PG8_SCHED;
            PG8_LDB(B1, 0, 1); PG8_STAGE(PG8_SB(0, 0), b2, voffB);
            PG8_BAR; PG8_WAIT_L(0); PG8_MMA(0, 1, At, B1); PG8_BAR;
            PG8_LDA(At, 0, 1); PG8_STAGE(PG8_SA(0, 0), a2, voffA);
            PG8_BAR; PG8_WAIT_L(0); PG8_MMA(1, 0, At, B0); PG8_BAR; PG8_SCHED;
            PG8_STAGE(PG8_SB(0, 1), b2 + hstep, voffB);
            PG8_WAIT_V(6); PG8_BAR; PG8_MMA(1, 1, At, B1); PG8_BAR;
            PG8_LDB(B0, 1, 0); PG8_SCHED; PG8_LDA(At, 1, 0); PG8_STAGE(PG8_SA(0, 1), a2 + hstep, voffA);
            PG8_WAIT_L(8); PG8_BAR; PG8_WAIT_L(0); PG8_MMA(0, 0, At, B0); PG8_BAR; PG8_SCHED;
            PG8_LDB(B1, 1, 1); PG8_STAGE(PG8_SB(1, 0), b3, voffB);
            PG8_BAR; PG8_WAIT_L(0); PG8_MMA(0, 1, At, B1); PG8_BAR;
            PG8_LDA(At, 1, 1); PG8_STAGE(PG8_SA(1, 0), a3, voffA);
            PG8_BAR; PG8_WAIT_L(0); PG8_MMA(1, 0, At, B0); PG8_BAR; PG8_SCHED;
            PG8_STAGE(PG8_SB(1, 1), b3 + hstep, voffB);
            PG8_WAIT_V(6); PG8_BAR; PG8_MMA(1, 1, At, B1); PG8_BAR;
            }
        }
        if constexpr (ALIGN_EPI) { if (wr == 0) PG8_BAR; }
        PG8_HOOK_PRE(); if constexpr (!Epi::AFTER_DRAIN) { E(acc, cur, wr, wc, fr, fq); S.done(cur); } PG8_HOOK_POST();
        if (!has_next) break;
#pragma unroll
        for (int a = 0; a < 2; ++a)
#pragma unroll
            for (int b = 0; b < 2; ++b)
#pragma unroll
                for (int m = 0; m < 4; ++m)
#pragma unroll
                    for (int n = 0; n < 2; ++n) acc[a][b][m][n] = (f32x4){0.f, 0.f, 0.f, 0.f};
        cur = nxt; cA = nA; cB = nB; ++ui;
        if constexpr (ALIGN_EPI) { if (wr == 1) PG8_BAR; }
    }
    PG8_WAIT_V(0);
    if constexpr (!ALIGN_EPI) { if (wr == 0) PG8_BAR; }
    PG8_BAR;
    if constexpr (Epi::AFTER_DRAIN) { E.fused(acc, cur, wr, wc, fr, fq, lds, wid, lane); S.done(cur); }
#undef PG8_SA
#undef PG8_SB
#undef PG8_STAGE
#undef PG8_LDA
#undef PG8_LDB
#undef PG8_MMA
#undef PG8_WAIT_V
#undef PG8_WAIT_L
#undef PG8_BAR
#undef PG8_SCHED
}
}

constexpr int NWAVES = 8, NTHR = 512;
constexpr int BATCH = 8, SEQ = 2048, DM = 2048, MTOK = BATCH * SEQ, DFF = 5504, NGU = 2 * DFF;
constexpr int NIN = 12368, NA = 8192, NIKW = 80, NB = 4096, NAB = NA + NB;
constexpr int KVW = 512, IQW = 1024;
constexpr float RMS_EPS = 1e-6f;
constexpr float LOG2E = 1.4426950408889634f;

constexpr size_t MiB = 1u << 20;
constexpr size_t WS_CTL = 0, CTL_ZERO_BYTES = 1 * MiB;
constexpr size_t WS_WGU = 2 * MiB;
constexpr size_t WS_WD = 45 * MiB;
constexpr size_t WS_WGU2 = 67 * MiB, WS_WD2 = 110 * MiB;
constexpr size_t WS_WA = 132 * MiB;
constexpr size_t WS_WB = 164 * MiB;
constexpr size_t WS_WPR = 180 * MiB, WS_WPA = 188 * MiB, WS_WOUT = 196 * MiB;
constexpr size_t WS_RGA = 204 * MiB, WS_RGX = WS_RGA + MiB / 2;
constexpr size_t WS_WIKT = 205 * MiB;
constexpr size_t WS_XB = 206 * MiB;
constexpr size_t WS_ACT = 270 * MiB;
constexpr size_t WS_Q = 270 * MiB;
constexpr size_t WS_K = 334 * MiB;
constexpr size_t WS_VT = 350 * MiB;
constexpr size_t WS_IQ = 366 * MiB;
constexpr size_t WS_IK = 398 * MiB;
constexpr size_t WS_IW = 400 * MiB;
constexpr size_t WS_MASK = 402 * MiB;
constexpr size_t WS_SS1 = 205 * MiB + MiB / 2, WS_SS2 = 1 * MiB;
constexpr size_t WS_SGR = 406 * MiB;
constexpr size_t WS_SGA = 2 * MiB;
constexpr size_t WS_END = 470 * MiB;
constexpr size_t OUT_RX = 0, OUT_RG = 64 * MiB;
static_assert(WS_ACT + (size_t)MTOK * DFF * 2 == 442 * MiB && WS_WGU + (size_t)NGU * DM * 2 == WS_WD && WS_WD + (size_t)DM * DFF * 2 <= WS_WGU2 && WS_WGU2 + (size_t)NGU * DM * 2 == WS_WD2, "map");
constexpr int CW_BAR = 4096;

constexpr int RING_OFF = 0, RING_BYTES = 131072;
constexpr int LDS_BYTES = 163840;
constexpr int XTRA_OFF = 131072;
constexpr int LDSCTL_OFF = LDS_BYTES - 512, MISC_OFF = LDSCTL_OFF + 320;
#define GAS __attribute__((address_space(1)))
#define LAS __attribute__((address_space(3)))
typedef unsigned short bf16;
typedef unsigned v4u __attribute__((ext_vector_type(4)));
typedef float f32x4 __attribute__((ext_vector_type(4)));
typedef short bf16x8 __attribute__((ext_vector_type(8)));
typedef GAS unsigned gu32;
typedef GAS unsigned long long gu64;
#define RLX_AGENT __ATOMIC_RELAXED, __HIP_MEMORY_SCOPE_AGENT
#define LDS_WAIT() asm volatile("s_waitcnt lgkmcnt(0)" ::: "memory")
#define VM_WAIT() asm volatile("s_waitcnt vmcnt(0)" ::: "memory")
__device__ __forceinline__ unsigned long long rt() { return __builtin_amdgcn_s_memrealtime(); }
__device__ __forceinline__ unsigned f2bf(float f) { unsigned u = __builtin_bit_cast(unsigned, f); return (u + 0x7fffu + ((u >> 16) & 1u)) >> 16; }
__device__ __forceinline__ unsigned pk2(float lo, float hi) { return f2bf(lo) | (f2bf(hi) << 16); }

#define XB_TMO      128
#define XB_XCNT(j)  (256  + 64 * (j))
#define XB_XSUB(j)  (1280 + 64 * (j))
#define XB_XGEN(j)  (2304 + 64 * (j))
#define XB_TOP      3328
#define XB_TOPGEN   3392
#define XCD_BAR_WORDS 3456
#define XB_SPIN_CAP (1u << 18)

__device__ __forceinline__ unsigned xb_ld(unsigned* p)              { return __hip_atomic_load(p, __ATOMIC_RELAXED, __HIP_MEMORY_SCOPE_AGENT); }
__device__ __forceinline__ unsigned xb_add(unsigned* p, unsigned v) { return __hip_atomic_fetch_add(p, v, __ATOMIC_RELAXED, __HIP_MEMORY_SCOPE_AGENT); }
__device__ __forceinline__ unsigned xb_xcc_id() { return (unsigned)__builtin_amdgcn_s_getreg((3 << 11) | 20) & 0xFu; }
#define XB_SPIN(cond, bar) do { unsigned _sp = 0; while (cond) { __builtin_amdgcn_s_sleep(1); \
    if ((++_sp & 255u) == 0u) { if (xb_ld(&(bar)[XB_TMO])) break; if (_sp > XB_SPIN_CAP) { atomicAdd(&(bar)[XB_TMO], 1u); break; } } } } while (0)

struct XcdBarrier {
    unsigned* bar; unsigned x;
    volatile LAS unsigned* st;
};

__device__ __forceinline__ XcdBarrier xcd_barrier_post(unsigned* bar, volatile LAS unsigned* st) {
    XcdBarrier b; b.bar = bar; b.x = xb_xcc_id(); b.st = st;
    if (threadIdx.x == 0) (void)xb_add(&bar[XB_XCNT(b.x)], 1u);
    return b;
}
__device__ __forceinline__ void xcd_barrier_complete(unsigned* bar, unsigned x, unsigned& nloc, unsigned& nx) {
    const unsigned G = gridDim.x * gridDim.y * gridDim.z;
    unsigned sum, cnt, mine, sp = 0u;
    for (;;) {
        sum = 0u; cnt = 0u; mine = 0u;
#pragma unroll
        for (unsigned j = 0; j < 16; ++j) { const unsigned c = xb_ld(&bar[XB_XCNT(j)]); sum += c; cnt += (c > 0u) ? 1u : 0u; mine = (j == x) ? c : mine; }
        if (sum == G) break;
        __builtin_amdgcn_s_sleep(1);
        if ((++sp & 255u) == 0u) { if (xb_ld(&bar[XB_TMO])) break; if (sp > XB_SPIN_CAP) { atomicAdd(&bar[XB_TMO], 1u); break; } }
    }
    nloc = mine > 0u ? mine : 1u; nx = cnt > 0u ? cnt : 1u;
}

__device__ __forceinline__ void xcd_barrier(const XcdBarrier& b) {
    asm volatile("s_waitcnt vmcnt(0)" ::: "memory");
    __syncthreads();
    if (threadIdx.x == 0) {
        unsigned* bar = b.bar;
        __builtin_amdgcn_s_waitcnt(0);
        unsigned nloc = b.st[0], nx = b.st[1];
        if (nloc == 0u) { xcd_barrier_complete(bar, b.x, nloc, nx); b.st[0] = nloc; b.st[1] = nx; }
        const unsigned old = xb_add(&bar[XB_XSUB(b.x)], 1u);
        const unsigned gen = old / nloc;
        if (old + 1u == (gen + 1u) * nloc) {
            __builtin_amdgcn_fence(__ATOMIC_RELEASE, "agent");
            asm volatile("s_waitcnt vmcnt(0)" ::: "memory");
            const unsigned og = xb_add(&bar[XB_TOP], 1u);
            const unsigned tg = og / nx;
            if (og + 1u == (tg + 1u) * nx) xb_add(&bar[XB_TOPGEN], 1u);
            else XB_SPIN(xb_ld(&bar[XB_TOPGEN]) == tg, bar);
            __builtin_amdgcn_fence(__ATOMIC_ACQUIRE, "agent");
            xb_add(&bar[XB_XGEN(b.x)], 1u);
            asm volatile("s_waitcnt vmcnt(0)" ::: "memory");
        } else {
            XB_SPIN(xb_ld(&bar[XB_XGEN(b.x)]) == gen, bar);
            __builtin_amdgcn_fence(__ATOMIC_ACQUIRE, "agent");
            asm volatile("s_waitcnt vmcnt(0)" ::: "memory");
        }
    }
    __syncthreads();
}

typedef float f32x16 __attribute__((ext_vector_type(16)));
typedef short s16x4 __attribute__((ext_vector_type(4)));
typedef unsigned v2u __attribute__((ext_vector_type(2)));

__device__ __forceinline__ float bf2f(unsigned short h) { return __builtin_bit_cast(float, (unsigned)h << 16); }
__device__ __forceinline__ float fast_exp2(float x) { return __builtin_amdgcn_exp2f(x); }
__device__ __forceinline__ float fast_rcp(float x) { return __builtin_amdgcn_rcpf(x); }
__device__ __forceinline__ float sigmoidf_(float x) { return fast_rcp(1.0f + fast_exp2(-x * LOG2E)); }
__device__ __forceinline__ float siluf_(float x) { return x * sigmoidf_(x); }
__device__ __forceinline__ float gelu_tanh(float x) { const float u = 0.7978845608028654f * (x + 0.044715f * x * x * x); return x * sigmoidf_(2.0f * u); }
typedef __bf16 bf16x2_t __attribute__((ext_vector_type(2)));
typedef float f32x2_t __attribute__((ext_vector_type(2)));
__device__ __forceinline__ unsigned cvtpk(float lo, float hi) { const f32x2_t v = {lo, hi}; const bf16x2_t b = __builtin_convertvector(v, bf16x2_t); return __builtin_bit_cast(unsigned, b); }
__device__ __forceinline__ float wave_sum(float v) {
#pragma unroll
    for (int o = 1; o < 64; o <<= 1) v += __shfl_xor(v, o);
    return v;
}

typedef pg8::f32x4 pf4;
typedef pg8::u32x4 pu4;
__device__ __forceinline__ float bfl(unsigned w) { return __builtin_bit_cast(float, w << 16); }
__device__ __forceinline__ float bfh(unsigned w) { return __builtin_bit_cast(float, w & 0xffff0000u); }
__device__ __forceinline__ void load_rstd(const float* ss, int row0, float (&rs)[2][4]) {
#pragma unroll
    for (int ai = 0; ai < 2; ++ai)
#pragma unroll
        for (int m = 0; m < 4; ++m) {
            const pf4* p = (const pf4*)(ss + (size_t)(row0 + ai * 128 + m * 16) * 8); const pf4 a = p[0], b = p[1];
            const float s = ((a[0] + a[1]) + (a[2] + a[3])) + ((b[0] + b[1]) + (b[2] + b[3]));
            rs[ai][m] = __builtin_amdgcn_rsqf(s * (1.0f / DM) + RMS_EPS);
        }
}
template <bool SCALE> struct EpiSwiGLU {
    static constexpr bool PERM = true, AFTER_DRAIN = false;
    bf16* O; const float* ss;
    __device__ __forceinline__ void operator()(const pf4 (&acc)[2][2][4][2], const pg8::Unit& u, int wr, int wc, int fr, int fq) const {
        const int row0 = u.pm * 256 + wr * 64 + fr, col = u.pn * 128 + wc * 32 + 8 * fq;
        float rs[2][4];
        if (SCALE) load_rstd(ss, row0, rs);
#pragma unroll
        for (int ai = 0; ai < 2; ++ai)
#pragma unroll
            for (int m = 0; m < 4; ++m) {
                bf16* rowp = O + (size_t)(row0 + ai * 128 + m * 16) * DFF + col;
                pf4 g0 = acc[ai][0][m][0], g1 = acc[ai][0][m][1], u0 = acc[ai][1][m][0], u1 = acc[ai][1][m][1];
                if (SCALE) { const float r = rs[ai][m]; g0 *= r; g1 *= r; u0 *= r; u1 *= r; }
                pu4 w;
                w.x = cvtpk(siluf_(g0[0]) * u0[0], siluf_(g0[1]) * u0[1]); w.y = cvtpk(siluf_(g0[2]) * u0[2], siluf_(g0[3]) * u0[3]);
                w.z = cvtpk(siluf_(g1[0]) * u1[0], siluf_(g1[1]) * u1[1]); w.w = cvtpk(siluf_(g1[2]) * u1[2], siluf_(g1[3]) * u1[3]);
                *(pu4*)rowp = w;
            }
    }
};
template <bool F32BASE> struct EpiResidB {
    static constexpr bool PERM = true, AFTER_DRAIN = false;
    const float* basef; bf16* xb; float alpha; float* ss; LAS float* part;
    __device__ __forceinline__ void operator()(const pf4 (&acc)[2][2][4][2], const pg8::Unit& u, int wr, int wc, int fr, int fq) const {
        const int row0 = u.pm * 256 + wr * 64 + fr, col = u.pn * 256 + wc * 32 + 8 * fq;
#pragma unroll
        for (int ai = 0; ai < 2; ++ai)
#pragma unroll
            for (int m = 0; m < 4; ++m) {
                float sq = 0.f;
#pragma unroll
                for (int bj = 0; bj < 2; ++bj) {
                    const size_t ro = (size_t)(row0 + ai * 128 + m * 16) * DM + col + bj * 128;
                    float b[8];
                    if (F32BASE) { const pf4 b0 = *(const pf4*)(basef + ro), b1 = *(const pf4*)(basef + ro + 4);
#pragma unroll
                        for (int j = 0; j < 4; ++j) { b[j] = b0[j]; b[4 + j] = b1[j]; } }
                    else { const pu4 bw = *(const pu4*)(xb + ro);
#pragma unroll
                        for (int j = 0; j < 4; ++j) { b[2 * j] = bfl(bw[j]); b[2 * j + 1] = bfh(bw[j]); } }
                    const pf4 v0 = acc[ai][bj][m][0], v1 = acc[ai][bj][m][1];
                    pu4 w;
                    w.x = cvtpk(b[0] + alpha * v0[0], b[1] + alpha * v0[1]); w.y = cvtpk(b[2] + alpha * v0[2], b[3] + alpha * v0[3]);
                    w.z = cvtpk(b[4] + alpha * v1[0], b[5] + alpha * v1[1]); w.w = cvtpk(b[6] + alpha * v1[2], b[7] + alpha * v1[3]);
                    *(pu4*)(xb + ro) = w;
#pragma unroll
                    for (int j = 0; j < 4; ++j) { const float lo = bfl(w[j]), hi = bfh(w[j]); sq += lo * lo + hi * hi; }
                }
                sq += __shfl_xor(sq, 16); sq += __shfl_xor(sq, 32);
                if (fq == 0) part[(ai * 128 + wr * 64 + m * 16 + fr) * 4 + wc] = sq;
            }
        asm volatile("s_waitcnt lgkmcnt(0)" ::: "memory"); __builtin_amdgcn_s_barrier(); asm volatile("" ::: "memory");
        const int tid = (wr * 4 + wc) * 64 + fq * 16 + fr;
        if (tid < 256) { const pf4 p = *(const LAS pf4*)(part + tid * 4); ss[(size_t)(u.pm * 256 + tid) * 8 + u.pn] = (p[0] + p[1]) + (p[2] + p[3]); }
    }
};
struct EpiProjA {
    static constexpr bool PERM = true, AFTER_DRAIN = false;
    unsigned char* ws; bf16* rxp; bf16* rgp; const float* ss;
    __device__ __forceinline__ void operator()(const pf4 (&acc)[2][2][4][2], const pg8::Unit& u, int wr, int wc, int fr, int fq) const {
        const int pn = u.pn, row0 = u.pm * 256 + wr * 64 + fr, cw = wc * 32 + 8 * fq;
        float rs[2][4]; load_rstd(ss, row0, rs);
        if (pn < 26 || pn >= 28) {
            bf16* base; int ldc, ct; bool gel = false, sig = false;
            if (pn < 8) { base = rxp; ldc = DM; ct = pn; }
            else if (pn < 16) { base = rgp; ldc = DM; ct = pn - 8; gel = true; }
            else if (pn < 24) { base = (bf16*)(ws + WS_Q); ldc = DM; ct = pn - 16; }
            else if (pn < 26) { base = (bf16*)(ws + WS_K); ldc = KVW; ct = pn - 24; }
            else if (pn < 32) { base = (bf16*)(ws + WS_IQ); ldc = IQW; ct = pn - 28; }
            else if (pn < 40) { base = (bf16*)(ws + WS_SGR); ldc = DM; ct = pn - 32; sig = true; }
            else { base = (bf16*)(ws + WS_SGA); ldc = DM; ct = pn - 40; sig = true; }
#pragma unroll
            for (int ai = 0; ai < 2; ++ai)
#pragma unroll
                for (int m = 0; m < 4; ++m) {
                    bf16* rowp = base + (size_t)(row0 + ai * 128 + m * 16) * ldc + ct * 256 + cw;
                    const float r = rs[ai][m];
#pragma unroll
                    for (int bj = 0; bj < 2; ++bj) {
                        pf4 v0 = acc[ai][bj][m][0] * r, v1 = acc[ai][bj][m][1] * r;
                        if (gel) {
#pragma unroll
                            for (int j = 0; j < 4; ++j) { v0[j] = gelu_tanh(v0[j]); v1[j] = gelu_tanh(v1[j]); }
                        }
                        if (sig) {
#pragma unroll
                            for (int j = 0; j < 4; ++j) { v0[j] = sigmoidf_(v0[j]); v1[j] = sigmoidf_(v1[j]); }
                        }
                        pu4 w; w.x = cvtpk(v0[0], v0[1]); w.y = cvtpk(v0[2], v0[3]); w.z = cvtpk(v1[0], v1[1]); w.w = cvtpk(v1[2], v1[3]);
                        *(pu4*)(rowp + bj * 128) = w;
                    }
                }
        } else {
            bf16* vt = (bf16*)(ws + WS_VT);
#pragma unroll
            for (int ai = 0; ai < 2; ++ai)
#pragma unroll
                for (int m = 0; m < 4; ++m) {
                    const int row = row0 + ai * 128 + m * 16, b = row >> 11, s = row & 2047;
                    const float r = rs[ai][m];
#pragma unroll
                    for (int bj = 0; bj < 2; ++bj) {
                        const int dabs = (pn - 26) * 256 + bj * 128 + cw;
                        bf16* p = vt + ((size_t)(b * 4 + (dabs >> 7)) * 128 + (dabs & 127)) * SEQ + s;
                        const pf4 v0 = acc[ai][bj][m][0] * r, v1 = acc[ai][bj][m][1] * r;
#pragma unroll
                        for (int j = 0; j < 4; ++j) { p[(size_t)j * SEQ] = (bf16)f2bf(v0[j]); p[(size_t)(4 + j) * SEQ] = (bf16)f2bf(v1[j]); }
                    }
                }
        }
    }
};
template <bool ADD> struct EpiGateMul {
    static constexpr bool PERM = true, AFTER_DRAIN = false;
    const bf16* G; bf16* O;
    __device__ __forceinline__ void operator()(const pf4 (&acc)[2][2][4][2], const pg8::Unit& u, int wr, int wc, int fr, int fq) const {
        const int row0 = u.pm * 256 + wr * 64 + fr, col = u.pn * 256 + wc * 32 + 8 * fq;
#pragma unroll
        for (int ai = 0; ai < 2; ++ai)
#pragma unroll
            for (int m = 0; m < 4; ++m) {
                const size_t ro = (size_t)(row0 + ai * 128 + m * 16) * DM + col;
#pragma unroll
                for (int bj = 0; bj < 2; ++bj) {
                    const pu4 g = *(const pu4*)(G + ro + bj * 128);
                    pu4 o = (pu4){0u, 0u, 0u, 0u}; if (ADD) o = *(const pu4*)(O + ro + bj * 128);
                    const pf4 v0 = acc[ai][bj][m][0], v1 = acc[ai][bj][m][1];
                    float r[8];
#pragma unroll
                    for (int j = 0; j < 4; ++j) {
                        const float a0 = j < 2 ? v0[2 * j] : v1[2 * j - 4], a1 = j < 2 ? v0[2 * j + 1] : v1[2 * j - 3];
                        r[2 * j] = bfl(g[j]) * a0 + (ADD ? bfl(o[j]) : 0.f);
                        r[2 * j + 1] = bfh(g[j]) * a1 + (ADD ? bfh(o[j]) : 0.f);
                    }
                    pu4 w; w.x = cvtpk(r[0], r[1]); w.y = cvtpk(r[2], r[3]); w.z = cvtpk(r[4], r[5]); w.w = cvtpk(r[6], r[7]);
                    *(pu4*)(O + ro + bj * 128) = w;
                }
            }
    }
};


__device__ __forceinline__ void ikiw_unit(unsigned char* ws, LAS unsigned char* lds, int blk, int tid) {
    const int lane = tid & 63, wave = __builtin_amdgcn_readfirstlane(tid >> 6), fr = lane & 15, fq = lane >> 4, rt = wave & 3, kh = wave >> 2;
    const bf16* ap = (const bf16*)(ws + WS_XB) + (size_t)(64 * blk + 16 * rt + fr) * DM + kh * 1024 + 8 * fq;
    const bf16* bp = (const bf16*)(ws + WS_WIKT) + (size_t)fr * DM + kh * 1024 + 8 * fq;
    pf4 acc[5];
#pragma unroll
    for (int ct = 0; ct < 5; ++ct) acc[ct] = (pf4){0.f, 0.f, 0.f, 0.f};
#pragma unroll 4
    for (int ks = 0; ks < 32; ++ks) {
        const bf16x8 a = *(const bf16x8*)(ap + 32 * ks);
#pragma unroll
        for (int ct = 0; ct < 5; ++ct) { const bf16x8 bfr = *(const bf16x8*)(bp + (size_t)ct * 16 * DM + 32 * ks); acc[ct] = __builtin_amdgcn_mfma_f32_16x16x32_bf16(a, bfr, acc[ct], 0, 0, 0); }
    }
    LAS pf4* red = (LAS pf4*)lds;
    if (kh == 1) {
#pragma unroll
        for (int ct = 0; ct < 5; ++ct) red[(rt * 5 + ct) * 64 + lane] = acc[ct];
    }
    __syncthreads();
    if (kh == 0) {
        const float* ss = (const float*)(ws + WS_SS1); bf16* IK = (bf16*)(ws + WS_IK); float* IW = (float*)(ws + WS_IW);
#pragma unroll
        for (int i = 0; i < 4; ++i) {
            const int row = 64 * blk + 16 * rt + 4 * fq + i;
            const pf4* p = (const pf4*)(ss + (size_t)row * 8); const pf4 a = p[0], b = p[1];
            const float rstd = __builtin_amdgcn_rsqf((((a[0] + a[1]) + (a[2] + a[3])) + ((b[0] + b[1]) + (b[2] + b[3]))) * (1.0f / DM) + RMS_EPS);
#pragma unroll
            for (int ct = 0; ct < 5; ++ct) {
                const float v = (acc[ct][i] + red[(rt * 5 + ct) * 64 + lane][i]) * rstd;
                if (ct < 4) IK[(size_t)row * 64 + 16 * ct + fr] = (bf16)f2bf(v); else IW[(size_t)row * 16 + fr] = v * 0.03125f;
            }
        }
    }
    __syncthreads();
}

struct TrJob { const float* W; bf16* dst; const float* gs; int ldw, ncols, Kdst, row0, k0, n0; };
struct TrRegs { f32x4 v[8]; f32x4 g0, g1; };
__device__ __forceinline__ void tr_load(const TrJob& j, TrRegs& r, int lane) {
    const int cq = (lane & 7) * 4; const bool cv = (j.n0 + cq) < j.ncols;
    const float* p = j.W + (size_t)(j.k0 + (lane >> 3)) * j.ldw + j.n0 + cq;
#pragma unroll
    for (int i = 0; i < 8; ++i) r.v[i] = cv ? *(const f32x4*)(p + (size_t)(8 * i) * j.ldw) : (f32x4){0.f, 0.f, 0.f, 0.f};
    if (j.gs) { const f32x4* g = (const f32x4*)(j.gs + j.k0 + 8 * (lane & 7)); r.g0 = g[0]; r.g1 = g[1]; }
    else { r.g0 = (f32x4){1.f, 1.f, 1.f, 1.f}; r.g1 = r.g0; }
}
__device__ __forceinline__ void tr_finish(const TrJob& j, const TrRegs& r, LAS float* scr, int lane) {
    const int cq = (lane & 7) * 4, kr = lane >> 3;
#pragma unroll
    for (int i = 0; i < 8; ++i) { LAS float* s = scr + (8 * i + kr) * 33 + cq; s[0] = r.v[i].x; s[1] = r.v[i].y; s[2] = r.v[i].z; s[3] = r.v[i].w; }
    LDS_WAIT(); asm volatile("" ::: "memory");
    const int c = lane & 7;
#pragma unroll
    for (int jj = 0; jj < 4; ++jj) { const int n = (lane >> 3) + 8 * jj; const LAS float* s = scr + (8 * c) * 33 + n;
        v4u o; o.x = cvtpk(s[0 * 33] * r.g0.x, s[1 * 33] * r.g0.y); o.y = cvtpk(s[2 * 33] * r.g0.z, s[3 * 33] * r.g0.w);
        o.z = cvtpk(s[4 * 33] * r.g1.x, s[5 * 33] * r.g1.y); o.w = cvtpk(s[6 * 33] * r.g1.z, s[7 * 33] * r.g1.w);
        if (j.n0 + n < j.ncols) *(GAS v4u*)(j.dst + (size_t)(j.row0 + n) * j.Kdst + j.k0 + 8 * c) = o; }
    LDS_WAIT(); asm volatile("" ::: "memory");
}
constexpr int IG_FFN = (DM / 64) * (DFF / 32);
constexpr int N_FFN_ITEMS = 3 * IG_FFN;
constexpr int I_WA = 32 * 256, I_WK = 32 * 3, I_WB = 32 * 128, I_SQ = 32 * 64, I_RG = 128;
constexpr int N_MIX_ITEMS = I_WA + I_WK + I_WB + 3 * I_SQ + 2 * I_RG;
constexpr int N_CONV_ITEMS = 2 * N_FFN_ITEMS + N_MIX_ITEMS;
__device__ __forceinline__ void ffn_job(const float* wg, const float* wu, const float* wd, bf16* dgu, bf16* dd, const float* gs, int r, TrJob& j) {
    if (r < 2 * IG_FFN) { const bool up = r >= IG_FFN; const int rr = up ? r - IG_FFN : r; const int kb = rr / (DFF / 32), nb = rr % (DFF / 32), n0 = nb * 32;
        j = TrJob{up ? wu : wg, dgu, gs, DFF, DFF, DM, 256 * (n0 >> 7) + (up ? 128 : 0) + (n0 & 127), kb * 64, n0}; }
    else { const int rr = r - 2 * IG_FFN; const int kb = rr / (DM / 32), nb = rr % (DM / 32);
        j = TrJob{wd, dd, nullptr, DM, DM, DFF, nb * 32, kb * 64, nb * 32}; }
}
__device__ __forceinline__ void conv_job(const float* const* in, unsigned char* ws, int r, TrJob& j) {
    if (r < N_FFN_ITEMS) { ffn_job(in[2], in[3], in[4], (bf16*)(ws + WS_WGU), (bf16*)(ws + WS_WD), nullptr, r, j); return; } r -= N_FFN_ITEMS;
    if (r < N_FFN_ITEMS) { ffn_job(in[19], in[20], in[21], (bf16*)(ws + WS_WGU2), (bf16*)(ws + WS_WD2), in[18], r, j); return; } r -= N_FFN_ITEMS;
    const float* gm = in[5];
    if (r < I_WA) { const int kb = r / 256, nb = r % 256; j = TrJob{in[6], (bf16*)(ws + WS_WA), gm, NIN, NA, DM, nb * 32, kb * 64, nb * 32}; return; } r -= I_WA;
    if (r < I_WK) { const int kb = r / 3, nb = r % 3; j = TrJob{in[6] + NA, (bf16*)(ws + WS_WIKT), gm, NIN, NIKW, DM, nb * 32, kb * 64, nb * 32}; return; } r -= I_WK;
    if (r < I_WB) { const int kb = r / 128, nb = r % 128; j = TrJob{in[6] + NA + NIKW, (bf16*)(ws + WS_WB), gm, NIN, NB, DM, nb * 32, kb * 64, nb * 32}; return; } r -= I_WB;
    if (r < 3 * I_SQ) { const int w = r / I_SQ, rr = r % I_SQ, kb = rr / 64, nb = rr % 64;
        const float* src = w == 0 ? in[15] : (w == 1 ? in[16] : in[17]); const size_t off = w == 0 ? WS_WPR : (w == 1 ? WS_WPA : WS_WOUT);
        j = TrJob{src, (bf16*)(ws + off), nullptr, DM, DM, DM, nb * 32, kb * 64, nb * 32}; return; } r -= 3 * I_SQ;
    { const int w = r / I_RG, rr = r % I_RG, mat = rr / 8, q = rr % 8, kb = q / 4, nb = q % 4;
      j = TrJob{(w ? in[11] : in[9]) + mat * 16384, (bf16*)(ws + (w ? WS_RGX : WS_RGA)) + mat * 16384, nullptr, 128, 128, 128, nb * 32, kb * 64, nb * 32}; }
}
__device__ __forceinline__ void conv_all(const float* const* in, unsigned char* ws, int gw, int NGW, LAS float* scr, int lane) {
    int it = gw; if (it >= N_CONV_ITEMS) return;
    TrJob jc, jn; TrRegs rc, rn;
    conv_job(in, ws, it, jc); tr_load(jc, rc, lane);
    for (;;) {
        const int itn = it + NGW; const bool more = itn < N_CONV_ITEMS;
        if (more) { conv_job(in, ws, itn, jn); tr_load(jn, rn, lane); }
        tr_finish(jc, rc, scr, lane);
        if (!more) break;
        jc = jn; rc = rn; it = itn;
    }
}
template <bool TO_F32>
__device__ __forceinline__ void rms_rows(const float* x, const float* g, void* outp, int gw, int NGW, int lane) {
    f32x4 gv[8];
#pragma unroll
    for (int j = 0; j < 8; ++j) gv[j] = ((const f32x4*)g)[lane + 64 * j];
    for (int m = gw; m < MTOK; m += NGW) {
        const f32x4* xr = (const f32x4*)(x + (size_t)m * DM) + lane;
        f32x4 v[8]; float s = 0.f;
#pragma unroll
        for (int j = 0; j < 8; ++j) { v[j] = xr[64 * j]; s += (v[j].x * v[j].x + v[j].y * v[j].y) + (v[j].z * v[j].z + v[j].w * v[j].w); }
        const float rstd = 1.0f / sqrtf(wave_sum(s) * (1.0f / DM) + RMS_EPS);
        if (TO_F32) { f32x4* o = (f32x4*)((float*)outp + (size_t)m * DM) + lane;
#pragma unroll
            for (int j = 0; j < 8; ++j) o[64 * j] = v[j] * rstd * gv[j]; }
        else { unsigned long long* o8 = (unsigned long long*)((bf16*)outp + (size_t)m * DM) + lane;
#pragma unroll
            for (int j = 0; j < 8; ++j) { const f32x4 y = v[j] * rstd * gv[j]; o8[64 * j] = (unsigned long long)cvtpk(y.x, y.y) | ((unsigned long long)cvtpk(y.z, y.w) << 32); } }
    }
}

__device__ __forceinline__ void rms_out_rows(const bf16* xb, const float* ss, const float* g, float* out, int gw, int NGW, int lane) {
    f32x4 gv[8];
#pragma unroll
    for (int j = 0; j < 8; ++j) gv[j] = ((const f32x4*)g)[lane + 64 * j];
    for (int m = gw; m < MTOK; m += NGW) {
        const f32x4* p = (const f32x4*)(ss + (size_t)m * 8); const f32x4 a = p[0], b = p[1];
        const float rstd = __builtin_amdgcn_rsqf((((a.x + a.y) + (a.z + a.w)) + ((b.x + b.y) + (b.z + b.w))) * (1.0f / DM) + RMS_EPS);
        const v2u* xr = (const v2u*)(xb + (size_t)m * DM) + lane;
        f32x4* o = (f32x4*)(out + (size_t)m * DM) + lane;
#pragma unroll
        for (int j = 0; j < 8; ++j) { const v2u w = xr[64 * j]; const f32x4 x = {bfl(w.x), bfh(w.x), bfl(w.y), bfh(w.y)}; o[64 * j] = x * rstd * gv[j]; }
    }
}
#ifdef PROBE_IDX
#define IDP(k) do { if (blockIdx.x == 0 && tid < 64) { asm volatile("s_waitcnt lgkmcnt(0)" ::: "memory"); __builtin_amdgcn_sched_barrier(0); const unsigned now_ = (unsigned)__builtin_amdgcn_s_memrealtime(); \
    volatile LAS unsigned* M_ = (volatile LAS unsigned*)(lds + MISC_OFF); if (tid == 0) { if ((k) != 0) M_[40 + (k)] += now_ - M_[39]; M_[39] = now_; } __builtin_amdgcn_sched_barrier(0); } } while (0)
#else
#define IDP(k) do { } while (0)
#endif
#ifdef PROBE_RNN
#define RTP(k) do { if (blockIdx.x == 0 && tid < 64) { asm volatile("s_waitcnt lgkmcnt(0)" ::: "memory"); __builtin_amdgcn_sched_barrier(0); const unsigned now_ = (unsigned)__builtin_amdgcn_s_memrealtime(); \
    volatile LAS unsigned* M_ = (volatile LAS unsigned*)(lds + MISC_OFF); if (tid == 0) { if ((k) != 0) M_[40 + (k)] += now_ - M_[39]; M_[39] = now_; } __builtin_amdgcn_sched_barrier(0); } } while (0)
#else
#define RTP(k) do { } while (0)
#endif
#ifdef PROBE_ATT
#define ATP(k) do { if (blockIdx.x == 0 && tid < 64) { asm volatile("s_waitcnt vmcnt(0) lgkmcnt(0)" ::: "memory"); __builtin_amdgcn_sched_barrier(0); const unsigned now_ = (unsigned)__builtin_amdgcn_s_memrealtime(); \
    volatile LAS unsigned* M_ = (volatile LAS unsigned*)(lds + MISC_OFF); if (tid == 0) { if ((k) != 0) M_[40 + (k)] += now_ - M_[39]; M_[39] = now_; } __builtin_amdgcn_sched_barrier(0); } } while (0)
#else
#define ATP(k) do { } while (0)
#endif

constexpr int RN_XCB = 0, RN_XCB_PITCH = 272, RN_XCB_SZ = 64 * 272;
constexpr int RN_XCF = 2 * RN_XCB_SZ, RN_XCF_SZ = 64 * 64 * 4;
constexpr int RN_PRE = RN_XCF + 2 * RN_XCF_SZ, RN_PP = 68;
constexpr int RN_PART = RN_PRE + 2 * 64 * 68 * 4;
constexpr int RN_CARRY = RN_PART + 4096;
static_assert(RN_CARRY + 512 <= 131072, "RG-LRU LDS map");
__device__ __forceinline__ void rnn_unit(const float* const* in, unsigned char* ws, const bf16* RX, bf16* RG, LAS unsigned char* lds, int unit, int tid) {
    const int lane = tid & 63, wave = __builtin_amdgcn_readfirstlane(tid >> 6);
    const int b = unit >> 5, n = (unit >> 1) & 15, hf = unit & 1;
    const int cg = tid & 15, tp = tid >> 4, chc = 128 * n + 8 * cg;
    float cw[4][8], cb[8];
#pragma unroll
    for (int k = 0; k < 4; ++k) { const f32x4 a = *(const f32x4*)(in[7] + k * DM + chc), c = *(const f32x4*)(in[7] + k * DM + chc + 4);
        cw[k][0] = a.x; cw[k][1] = a.y; cw[k][2] = a.z; cw[k][3] = a.w; cw[k][4] = c.x; cw[k][5] = c.y; cw[k][6] = c.z; cw[k][7] = c.w; }
    { const f32x4 a = *(const f32x4*)(in[8] + chc), c = *(const f32x4*)(in[8] + chc + 4); cb[0] = a.x; cb[1] = a.y; cb[2] = a.z; cb[3] = a.w; cb[4] = c.x; cb[5] = c.y; cb[6] = c.z; cb[7] = c.w; }
    const int chs = 128 * n + 64 * hf + lane;
    const float ba = in[10][chs], bx = in[12][chs];
    const float lam = in[13][chs];
    const float c8 = -8.0f * log1pf(expf(-lam));
    const int g = wave >> 2, ct = wave & 3, fr = lane & 15, fq = lane >> 4;
    bf16x8 Bf[4];
    { const bf16* wt = (const bf16*)(ws + (g ? WS_RGX : WS_RGA)) + (size_t)n * 16384 + (size_t)(64 * hf + 16 * ct + fr) * 128 + 8 * fq;
#pragma unroll
      for (int ks = 0; ks < 4; ++ks) Bf[ks] = *(const bf16x8*)(wt + 32 * ks); }
    LAS float* pre = (LAS float*)(lds + RN_PRE); LAS float* part = (LAS float*)(lds + RN_PART); LAS float* carry = (LAS float*)(lds + RN_CARRY);
    if (tid < 64) carry[tid] = 0.f;
    const float c8l = c8 * LOG2E;
    v4u vn[5]; unsigned short gn[8];
    const unsigned char* rxb = (const unsigned char*)RX; const unsigned char* rgb = (const unsigned char*)RG;
    const unsigned rxo = (unsigned)((b * SEQ * DM + chc) * 2), rgo = (unsigned)(((b * SEQ + 8 * wave) * DM + chs) * 2);
    constexpr int NCK = SEQ / 64;
#define RN_LOADX(ckk) do { const int ck_ = (ckk) < NCK ? (ckk) : NCK - 1; const int tb_ = ck_ * 64 + 2 * tp - 3; \
        _Pragma("unroll") for (int i = 0; i < 5; ++i) { const int tt_ = tb_ + i; const v4u x_ = *(const v4u*)(rxb + rxo + (unsigned)(tt_ < 0 ? 0 : tt_) * (DM * 2));     \
            vn[i] = tt_ >= 0 ? x_ : (v4u){0u, 0u, 0u, 0u}; } } while (0)
#define RN_LOADG(ckk) do { const int ck_ = (ckk) < NCK ? (ckk) : NCK - 1; const unsigned g_ = rgo + (unsigned)ck_ * (64 * DM * 2); \
        _Pragma("unroll") for (int i = 0; i < 8; ++i) gn[i] = *(const unsigned short*)(rgb + g_ + (unsigned)i * (DM * 2)); } while (0)
#define RN_CONV(v_, par_) do { _Pragma("unroll") for (int u = 0; u < 2; ++u) { float xc[8]; \
            _Pragma("unroll") for (int j = 0; j < 8; ++j) xc[j] = cb[j]; \
            _Pragma("unroll") for (int k = 0; k < 4; ++k) { const v4u r = v_[u + k]; \
                _Pragma("unroll") for (int j = 0; j < 4; ++j) { xc[2 * j] += cw[k][2 * j] * bfl(r[j]); xc[2 * j + 1] += cw[k][2 * j + 1] * bfh(r[j]); } } \
            const int t = 2 * tp + u; \
            const v4u w = {cvtpk(xc[0], xc[1]), cvtpk(xc[2], xc[3]), cvtpk(xc[4], xc[5]), cvtpk(xc[6], xc[7])}; \
            *(LAS v4u*)(lds + RN_XCB + (par_) * RN_XCB_SZ + t * RN_XCB_PITCH + cg * 16) = w; \
            if ((cg >> 3) == hf) { LAS f32x4* d = (LAS f32x4*)(lds + RN_XCF + (par_) * RN_XCF_SZ + (t * 64 + 8 * (cg & 7)) * 4); d[0] = (f32x4){xc[0], xc[1], xc[2], xc[3]}; d[1] = (f32x4){xc[4], xc[5], xc[6], xc[7]}; } } } while (0)
    RN_LOADX(0);
    { v4u v0[5];
#pragma unroll
      for (int i = 0; i < 5; ++i) v0[i] = vn[i];
      RN_LOADX(1); RN_LOADG(0);
      RN_CONV(v0, 0); }
    __syncthreads();
    for (int ck = 0; ck < NCK; ++ck) {
        const int t0 = ck * 64, par = ck & 1;
        RTP(0);
        v4u v[5]; unsigned short gl[8];
#pragma unroll
        for (int i = 0; i < 5; ++i) v[i] = vn[i];
#pragma unroll
        for (int i = 0; i < 8; ++i) gl[i] = gn[i];
        RN_LOADX(ck + 2); RN_LOADG(ck + 1);
        { pg8::f32x4 acc[4];
          const LAS unsigned char* xa = lds + RN_XCB + par * RN_XCB_SZ + fr * RN_XCB_PITCH + 16 * fq;
#pragma unroll
          for (int rt = 0; rt < 4; ++rt) acc[rt] = (pg8::f32x4){0.f, 0.f, 0.f, 0.f};
#pragma unroll
          for (int ks = 0; ks < 4; ++ks)
#pragma unroll
              for (int rt = 0; rt < 4; ++rt)
                  acc[rt] = __builtin_amdgcn_mfma_f32_16x16x32_bf16(*(const LAS bf16x8*)(xa + 16 * rt * RN_XCB_PITCH + 64 * ks), Bf[ks], acc[rt], 0, 0, 0);
          RN_CONV(v, par ^ 1);
#pragma unroll
          for (int rt = 0; rt < 4; ++rt)
#pragma unroll
              for (int i = 0; i < 4; ++i) pre[(g * 64 + 16 * rt + 4 * fq + i) * RN_PP + 16 * ct + fr] = acc[rt][i]; }
        RTP(3);
        __syncthreads();
        RTP(4);
        const LAS float* xcfp = (const LAS float*)(lds + RN_XCF + par * RN_XCF_SZ);
        float av[8], uv[8]; float Aloc = 1.f, Hloc = 0.f;
#pragma unroll
        for (int i = 0; i < 8; ++i) {
            const int t = 8 * wave + i;
            const float r = sigmoidf_(pre[t * RN_PP + lane] + ba), ig = sigmoidf_(pre[(64 + t) * RN_PP + lane] + bx);
            const float a = fast_exp2(c8l * r), mult = __builtin_amdgcn_sqrtf(fmaxf(1.0f - a * a, 0.f));
            const float uu = mult * (ig * xcfp[t * 64 + lane]);
            av[i] = a; uv[i] = uu; Hloc = a * Hloc + uu; Aloc *= a;
        }
        part[(wave * 64 + lane) * 2] = Aloc; part[(wave * 64 + lane) * 2 + 1] = Hloc;
        RTP(5);
        __syncthreads();
        RTP(6);
        float h = carry[(ck & 1) * 64 + lane];
        { f32x2_t ph[7];
#pragma unroll
          for (int s = 0; s < 7; ++s) ph[s] = *(const LAS f32x2_t*)(part + (s * 64 + lane) * 2);
#pragma unroll
          for (int s = 0; s < 7; ++s) if (s < wave) h = ph[s].x * h + ph[s].y; }
#pragma unroll
        for (int i = 0; i < 8; ++i) {
            h = av[i] * h + uv[i];
            *(unsigned short*)((unsigned char*)RG + rgo + (unsigned)ck * (64 * DM * 2) + (unsigned)i * (DM * 2)) = (unsigned short)f2bf(h * bf2f(gl[i]));
        }
        if (wave == 7) carry[((ck + 1) & 1) * 64 + lane] = h;
        RTP(7);
    }
#undef RN_LOADX
#undef RN_LOADG
#undef RN_CONV
    __syncthreads();
}

__device__ __forceinline__ void idx_scores(unsigned char* ws, LAS unsigned char* lds, int b, int qb, int tid) {
    const int lane = tid & 63, wave = __builtin_amdgcn_readfirstlane(tid >> 6), r32 = lane & 31, h = lane >> 5;
    const bf16* IQ = (const bf16*)(ws + WS_IQ); const bf16* IK = (const bf16*)(ws + WS_IK); const float* IW = (const float*)(ws + WS_IW);
    const int qa = 16 * qb + 2 * wave;
    const int qpos = qa + h;
    IDP(0);
    bf16x8 af[4];
    { const int qm = qa + ((r32 >> 2) & 1), hd = (r32 & 3) + 4 * (r32 >> 3);
      const bf16* p = IQ + (size_t)(b * SEQ + qm) * IQW + hd * 64 + 8 * h;
#pragma unroll
      for (int kk = 0; kk < 4; ++kk) af[kk] = *(const bf16x8*)(p + 16 * kk); }
    float wv[16];
    { const f32x4* p = (const f32x4*)(IW + (size_t)(b * SEQ + qpos) * 16);
#pragma unroll
      for (int j = 0; j < 4; ++j) { const f32x4 t = p[j]; wv[4 * j] = t.x; wv[4 * j + 1] = t.y; wv[4 * j + 2] = t.z; wv[4 * j + 3] = t.w; } }
    LAS float* sl = (LAS float*)(lds + wave * 16384 + h * 8192) + r32;
    const int kbmax = (16 * qb + 15) >> 5;
    const float NEG = -__builtin_inff();
    constexpr int IKP = 144, IKB = 64 * IKP;
    LAS unsigned char* stg = lds + XTRA_OFF;
    const int skey = tid >> 3, spart = tid & 7;
    const bf16* ikg = IK + (size_t)(b * SEQ + skey) * 64 + spart * 8;
    const int ntile = kbmax / 2 + 1;
    const int lt = ntile - 1;
#define IDX_LD(tt) (*(const v4u*)(ikg + (size_t)((tt) < lt ? (tt) : lt) * 64 * 64))
    v4u stA = IDX_LD(0), stB = IDX_LD(1);
    *(LAS v4u*)(stg + skey * IKP + spart * 16) = stA;
    *(LAS v4u*)(stg + IKB + skey * IKP + spart * 16) = stB;
    __syncthreads();
    stA = IDX_LD(2);
    f32x16 pa0, pa1, pb0, pb1;
    { const LAS unsigned char* bb = stg + r32 * IKP + 16 * h;
#pragma unroll
      for (int r = 0; r < 16; ++r) { pa0[r] = 0.f; pa1[r] = 0.f; }
#pragma unroll
      for (int kk = 0; kk < 4; ++kk) { pa0 = __builtin_amdgcn_mfma_f32_32x32x16_bf16(af[kk], *(const LAS bf16x8*)(bb + 32 * kk), pa0, 0, 0, 0);
                                       pa1 = __builtin_amdgcn_mfma_f32_32x32x16_bf16(af[kk], *(const LAS bf16x8*)(bb + 32 * IKP + 32 * kk), pa1, 0, 0, 0); } }
    __syncthreads();
#define IDX_STEP(bufo, n0_, n1_, c0_, c1_, t_, wr_) do { const LAS unsigned char* bb = stg + (bufo) + r32 * IKP + 16 * h; \
        bf16x8 bq[8]; \
        _Pragma("unroll") for (int kk = 0; kk < 4; ++kk) { bq[2 * kk] = *(const LAS bf16x8*)(bb + 32 * kk); bq[2 * kk + 1] = *(const LAS bf16x8*)(bb + 32 * IKP + 32 * kk); } \
        _Pragma("unroll") for (int r = 0; r < 16; ++r) { n0_[r] = 0.f; n1_[r] = 0.f; } \
        float s0_ = 0.f, s1_ = 0.f; \
        _Pragma("unroll") for (int kk = 0; kk < 4; ++kk) { \
            n0_ = __builtin_amdgcn_mfma_f32_32x32x16_bf16(af[kk], bq[2 * kk], n0_, 0, 0, 0); n1_ = __builtin_amdgcn_mfma_f32_32x32x16_bf16(af[kk], bq[2 * kk + 1], n1_, 0, 0, 0); \
            _Pragma("unroll") for (int r = 4 * kk; r < 4 * kk + 4; ++r) { s0_ += wv[r] * __builtin_amdgcn_fmed3f(c0_[r], 0.f, __builtin_inff()); s1_ += wv[r] * __builtin_amdgcn_fmed3f(c1_[r], 0.f, __builtin_inff()); } \
            __builtin_amdgcn_sched_group_barrier(0x008, 2, 0); __builtin_amdgcn_sched_group_barrier(0x002, 16, 0); } \
        if (wr_) { const int k0_ = 64 * (t_) + r32; sl[(2 * (t_)) * 32] = (k0_ <= qpos) ? s0_ : NEG; sl[(2 * (t_) + 1) * 32] = (k0_ + 32 <= qpos) ? s1_ : NEG; } } while (0)
    IDP(1);
    for (int t = 0; t < ntile; t += 2) {
        stB = IDX_LD(t + 3);
        IDP(0);
        IDX_STEP(IKB, pb0, pb1, pa0, pa1, t, true);
        IDP(7);
        *(LAS v4u*)(stg + skey * IKP + spart * 16) = stA;
        __syncthreads();
        stA = IDX_LD(t + 4);
        IDX_STEP(0, pa0, pa1, pb0, pb1, t + 1, (t + 1 < ntile));
        *(LAS v4u*)(stg + IKB + skey * IKP + spart * 16) = stB;
        __syncthreads();
    }
#undef IDX_STEP
#undef IDX_LD
    IDP(2);
    for (int kb = 2 * ntile; kb < 64; ++kb) sl[kb * 32] = NEG;
    LDS_WAIT(); asm volatile("" ::: "memory");
    IDP(3);
}
__device__ __forceinline__ int dpp_row_sum(int v) {
    v += __builtin_amdgcn_update_dpp(0, v, 0xB1, 0xF, 0xF, false);
    v += __builtin_amdgcn_update_dpp(0, v, 0x4E, 0xF, 0xF, false);
    v += __builtin_amdgcn_update_dpp(0, v, 0x141, 0xF, 0xF, false);
    v += __builtin_amdgcn_update_dpp(0, v, 0x140, 0xF, 0xF, false);
    return v;
}
__device__ __forceinline__ void idx_select(unsigned char* ws, LAS unsigned char* lds, int b, int qb, int tid) {
    const int lane = tid & 63, wave = __builtin_amdgcn_readfirstlane(tid >> 6), r32 = lane & 31, h = lane >> 5;
    unsigned* MASK = (unsigned*)(ws + WS_MASK);
    const int qa = 16 * qb + 2 * wave;
    LAS float* sl = (LAS float*)(lds + wave * 16384 + h * 8192) + r32;
    IDP(0);
    float sv[64];
#pragma unroll
    for (int j = 0; j < 64; ++j) sv[j] = sl[j * 32];
    const float NINF = -__builtin_inff();
    float T = -3.0e38f;
    bool doneA = (qa + 1 <= 256), doneB = (qa + 2 <= 256);
    if (!(doneA && doneB)) {
        float mn = 3.0e38f, mx = -3.0e38f;
#pragma unroll
        for (int j = 0; j < 64; ++j) { mx = fmaxf(mx, sv[j]); mn = fminf(mn, sv[j] == NINF ? 3.0e38f : sv[j]); }
#pragma unroll
        for (int o = 1; o < 32; o <<= 1) { mx = fmaxf(mx, __shfl_xor(mx, o)); mn = fminf(mn, __shfl_xor(mn, o)); }
        float lo = mn, hi = mx;
        bool done = h ? doneB : doneA;
        if (!done) T = lo;
        for (int it = 0; it < 64; ++it) {
            if (doneA && doneB) break;
            const float mid = lo + 0.5f * (hi - lo);
            unsigned bv0 = 0u, bv1 = 0u;
#pragma unroll
            for (int j = 0; j < 32; ++j) { bv0 = __builtin_amdgcn_alignbit(bv0, __builtin_bit_cast(unsigned, sv[j] - mid), 31); bv1 = __builtin_amdgcn_alignbit(bv1, __builtin_bit_cast(unsigned, sv[32 + j] - mid), 31); }
            int cnt = 64 - (__builtin_popcount(bv0) + __builtin_popcount(bv1));
            cnt = dpp_row_sum(cnt);
            const int cA = __builtin_amdgcn_readlane(cnt, 0) + __builtin_amdgcn_readlane(cnt, 16), cB = __builtin_amdgcn_readlane(cnt, 32) + __builtin_amdgcn_readlane(cnt, 48);
            const int c = h ? cB : cA;
            if (!done) {
                if (!(mid > lo && mid < hi)) { T = lo; done = true; }
                else if (c == 256) { T = mid; done = true; }
                else if (c > 256) { lo = mid; T = mid; }
                else hi = mid;
            }
            doneA = __builtin_amdgcn_readlane((int)done, 0) != 0; doneB = __builtin_amdgcn_readlane((int)done, 32) != 0;
        }
    }
    IDP(5);
    unsigned long long myw = 0ull;
#pragma unroll
    for (int j = 0; j < 64; ++j) { const unsigned long long bal = __ballot(sv[j] >= T); if (lane == j) myw = bal; }
    MASK[(size_t)(b * SEQ + qa) * 64 + lane] = (unsigned)myw;
    MASK[(size_t)(b * SEQ + qa + 1) * 64 + lane] = (unsigned)(myw >> 32);
    LDS_WAIT(); asm volatile("" ::: "memory");
    IDP(6);
}

constexpr int AT_KT = 64 * 256, AT_VP = 144, AT_VT = 128 * AT_VP, AT_BUF = AT_KT + AT_VT;
constexpr int AT_TBL = 2 * AT_BUF;
#define KSWZ(row, colB) ((row) * 256 + ((colB) ^ (((row) & 7) << 4)))
__device__ __forceinline__ int t5_bucket(int n) {
    if (n < 16) return n;
    const int th[16] = {19, 21, 24, 27, 31, 35, 40, 46, 52, 59, 67, 77, 87, 99, 113, 1 << 30};
    int bkt = 16;
#pragma unroll
    for (int i = 0; i < 15; ++i) bkt += (n >= th[i]) ? 1 : 0;
    return bkt;
}
__device__ __forceinline__ void attn_tile(unsigned char* ws, LAS unsigned char* lds, int b, int kvh, int t, int tid_in) {
    int tid = tid_in; asm volatile("" : "+v"(tid));
    const int lane = tid & 63, wave = __builtin_amdgcn_readfirstlane(tid >> 6), r32 = lane & 31, h = lane >> 5;
    const int g = wave >> 1, qs = wave & 1, hq = kvh * 4 + g;
    const int q = 64 * t + 32 * qs + r32;
    ATP(0);
    const unsigned qoff = (unsigned)WS_Q + (unsigned)(((b * SEQ + q) * DM + hq * 128) * 2);
    const unsigned moff = (unsigned)WS_MASK + (unsigned)((b * SEQ + q) * 64 * 4);
    const LAS float* tbl = (const LAS float*)(lds + AT_TBL) + g * 132;
    bf16x8 qr[8];
#pragma unroll
    for (int d0 = 0; d0 < 8; ++d0) qr[d0] = *(const bf16x8*)(ws + qoff + (d0 * 16 + h * 8) * 2);
    const int sr = tid >> 4, sc = (tid & 15) * 8;
    const int vd = tid >> 3, vp = tid & 7;
    const int kws = KSWZ(sr, sc * 2);
    const unsigned koff = (unsigned)WS_K + (unsigned)(((b * SEQ + sr) * KVW + kvh * 128 + sc) * 2);
    const unsigned voff = (unsigned)WS_VT + (unsigned)((((b * 4 + kvh) * 128 + vd) * SEQ + vp * 8) * 2);
    v4u sk0, sk1, sv0, sv1; v2u mw;
#define AT_LOAD(kt) do { const unsigned ko_ = koff + (unsigned)(kt) * (64 * KVW * 2); sk0 = *(const v4u*)(ws + ko_); sk1 = *(const v4u*)(ws + ko_ + 32 * KVW * 2); \
        const unsigned vo_ = voff + (unsigned)(kt) * 128; sv0 = *(const v4u*)(ws + vo_); sv1 = *(const v4u*)(ws + vo_ + 64 * SEQ * 2); } while (0)
#define AT_WRITE(bufo) do { LAS unsigned char* kb_ = lds + (bufo); *(LAS v4u*)(kb_ + kws) = sk0; *(LAS v4u*)(kb_ + kws + 32 * 256) = sk1; \
        LAS unsigned char* vb_ = kb_ + AT_KT + vd * AT_VP + (vp >> 1) * 32 + (vp & 1) * 8; *(LAS v2u*)vb_ = (v2u){sv0.x, sv0.y}; *(LAS v2u*)(vb_ + 16) = (v2u){sv0.z, sv0.w}; \
        *(LAS v2u*)(vb_ + 64 * AT_VP) = (v2u){sv1.x, sv1.y}; *(LAS v2u*)(vb_ + 64 * AT_VP + 16) = (v2u){sv1.z, sv1.w}; } while (0)
    AT_LOAD(0); AT_WRITE(0);
    v2u mwn = *(const v2u*)(ws + moff);
    __syncthreads();
    ATP(6);
    f32x16 o[4];
#pragma unroll
    for (int d = 0; d < 4; ++d)
#pragma unroll
        for (int r = 0; r < 16; ++r) o[d][r] = 0.f;
    float m_run = -1e30f, l_run = 0.f;
    const float C2 = 0.08838834764831845f * LOG2E;
    const float bfar = tbl[128];
    for (int kt = 0; kt <= t; ++kt) {
        const int bufo = (kt & 1) * AT_BUF;
        mw = mwn;
        ATP(0);
        f32x16 p0, p1;
#pragma unroll
        for (int r = 0; r < 16; ++r) { p0[r] = 0.f; p1[r] = 0.f; }
#pragma unroll
        for (int d0 = 0; d0 < 8; ++d0) {
            const LAS unsigned char* a = lds + bufo + KSWZ(r32, (d0 * 16 + h * 8) * 2);
            const bf16x8 a0 = *(const LAS bf16x8*)a, a1 = *(const LAS bf16x8*)(a + 32 * 256);
            p0 = __builtin_amdgcn_mfma_f32_32x32x16_bf16(a0, qr[d0], p0, 0, 0, 0);
            p1 = __builtin_amdgcn_mfma_f32_32x32x16_bf16(a1, qr[d0], p1, 0, 0, 0);
        }
        ATP(1);
        if (kt + 3 > t) {
            const int D0 = q - 64 * kt - 4 * h;
#pragma unroll
            for (int r = 0; r < 16; ++r) {
                const int c = (r & 3) + 8 * (r >> 2);
                unsigned i0 = (unsigned)(D0 - c), i1 = (unsigned)(D0 - 32 - c);
                i0 = i0 > 128u ? 128u : i0; i1 = i1 > 128u ? 128u : i1;
                p0[r] = p0[r] * C2 + tbl[i0]; p1[r] = p1[r] * C2 + tbl[i1];
            }
        } else {
#pragma unroll
            for (int r = 0; r < 16; ++r) { p0[r] = p0[r] * C2 + bfar; p1[r] = p1[r] * C2 + bfar; }
        }
        float mx = p0[0];
#pragma unroll
        for (int r = 1; r < 16; ++r) mx = fmaxf(mx, p0[r]);
#pragma unroll
        for (int r = 0; r < 16; ++r) mx = fmaxf(mx, p1[r]);
        mx = fmaxf(mx, __shfl_xor(mx, 32));
        if (!__all(mx <= m_run + 8.0f)) {
            const float mn = fmaxf(m_run, mx), alpha = fast_exp2(m_run - mn);
            m_run = mn; l_run *= alpha;
#pragma unroll
            for (int d = 0; d < 4; ++d)
#pragma unroll
                for (int r = 0; r < 16; ++r) o[d][r] *= alpha;
        }
        const int wl = (int)(mw.x >> (4 * h)), wh = (int)(mw.y >> (4 * h));
        float ps = 0.f;
#pragma unroll
        for (int r = 0; r < 16; ++r) {
            const int c = (r & 3) + 8 * (r >> 2);
            const unsigned e0 = __builtin_bit_cast(unsigned, fast_exp2(p0[r] - m_run)) & (unsigned)__builtin_amdgcn_sbfe(wl, c, 1);
            const unsigned e1 = __builtin_bit_cast(unsigned, fast_exp2(p1[r] - m_run)) & (unsigned)__builtin_amdgcn_sbfe(wh, c, 1);
            p0[r] = __builtin_bit_cast(float, e0); p1[r] = __builtin_bit_cast(float, e1);
            ps += p0[r] + p1[r];
        }
        l_run += ps;
        ATP(2);
        if (kt < t) { AT_LOAD(kt + 1); mwn = *(const v2u*)(ws + moff + 8u * (unsigned)(kt + 1)); }
        bf16x8 pk[4];
        { v4u w0 = {cvtpk(p0[0], p0[1]), cvtpk(p0[2], p0[3]), cvtpk(p0[4], p0[5]), cvtpk(p0[6], p0[7])}; pk[0] = __builtin_bit_cast(bf16x8, w0);
          v4u w1 = {cvtpk(p0[8], p0[9]), cvtpk(p0[10], p0[11]), cvtpk(p0[12], p0[13]), cvtpk(p0[14], p0[15])}; pk[1] = __builtin_bit_cast(bf16x8, w1);
          v4u w2 = {cvtpk(p1[0], p1[1]), cvtpk(p1[2], p1[3]), cvtpk(p1[4], p1[5]), cvtpk(p1[6], p1[7])}; pk[2] = __builtin_bit_cast(bf16x8, w2);
          v4u w3 = {cvtpk(p1[8], p1[9]), cvtpk(p1[10], p1[11]), cvtpk(p1[12], p1[13]), cvtpk(p1[14], p1[15])}; pk[3] = __builtin_bit_cast(bf16x8, w3); }
        { const LAS unsigned char* vb = lds + bufo + AT_KT + r32 * AT_VP + 16 * h;
#pragma unroll
          for (int dp = 0; dp < 1; ++dp)
#pragma unroll
              for (int ks = 0; ks < 4; ++ks)
#pragma unroll
                  for (int d0 = 0; d0 < 4; ++d0)
                      o[d0] = __builtin_amdgcn_mfma_f32_32x32x16_bf16(*(const LAS bf16x8*)(vb + d0 * 32 * AT_VP + 32 * ks), pk[ks], o[d0], 0, 0, 0); }
        ATP(3);
        if (kt < t) AT_WRITE(((kt + 1) & 1) * AT_BUF);
        ATP(4);
        __syncthreads();
        ATP(5);
    }
    ATP(0);
    const float lt = l_run + __shfl_xor(l_run, 32), rl = 1.0f / lt;
#pragma unroll
    for (int d0 = 0; d0 < 4; ++d0)
#pragma unroll
        for (int gq = 0; gq < 4; ++gq) {
            const v2u w = {cvtpk(o[d0][4 * gq] * rl, o[d0][4 * gq + 1] * rl), cvtpk(o[d0][4 * gq + 2] * rl, o[d0][4 * gq + 3] * rl)};
            *(v2u*)(ws + qoff + (32 * d0 + 8 * gq + 4 * h) * 2) = w;
        }
    ATP(7);
#undef AT_LOAD
#undef AT_WRITE
}
__device__ __forceinline__ void attn_unit(const float* rel_bias, unsigned char* ws, LAS unsigned char* lds, int unit, int tid) {
    const int b = unit >> 6, kvh = (unit >> 4) & 3, p = unit & 15;
    __syncthreads();
    for (int i = tid; i < 4 * 132; i += NTHR) { const int g = i / 132, d = i % 132;
        ((LAS float*)(lds + AT_TBL))[i] = rel_bias[(d >= 128 ? 31 : t5_bucket(d)) * 16 + kvh * 4 + g] * LOG2E; }
    __syncthreads();
    attn_tile(ws, lds, b, kvh, p, tid);
    attn_tile(ws, lds, b, kvh, 31 - p, tid);
}
__device__ __forceinline__ void attn_item(const float* rel_bias, unsigned char* ws, LAS unsigned char* lds, int b, int kvh, int t, int tid) {
    __syncthreads();
    for (int i = tid; i < 4 * 132; i += NTHR) { const int g = i / 132, d = i % 132;
        ((LAS float*)(lds + AT_TBL))[i] = rel_bias[(d >= 128 ? 31 : t5_bucket(d)) * 16 + kvh * 4 + g] * LOG2E; }
    __syncthreads();
    attn_tile(ws, lds, b, kvh, t, tid);
}


#ifndef MK_N_LAUNCHES
#define MK_N_LAUNCHES 1
#endif
constexpr int N_PHASES = 15;
struct Args { const float* in[23]; float* out; unsigned char* ws; int ph_lo, ph_hi; };
static_assert(sizeof(Args) == 23 * 8 + 8 + 8 + 8, "Args has no padding");

#ifndef STAG_US
#define STAG_US 3
#endif
__device__ __forceinline__ void stagger() { const unsigned long long t0 = rt(), w = (unsigned long long)((blockIdx.x & 3) * STAG_US * 100); while (rt() - t0 < w) __builtin_amdgcn_s_sleep(2); }
__global__ void __launch_bounds__(NTHR, 2) mk_fwd(Args args) {
    extern __shared__ __attribute__((aligned(16))) unsigned char lds_raw[];
    LAS unsigned char* lds = (LAS unsigned char*)lds_raw;
    volatile LAS unsigned* MISC = (volatile LAS unsigned*)(lds + MISC_OFF);
    const int tid = threadIdx.x, lane = tid & 63, wave = __builtin_amdgcn_readfirstlane(tid >> 6);
    const int G = gridDim.x;
    unsigned char* ws = args.ws;
    gu32* ctl = (gu32*)(ws + WS_CTL);
#ifdef PROBE_CLEAR
    for (int u = tid; u < LDS_BYTES / 4; u += NTHR) ((LAS unsigned*)lds)[u] = 0u;
#else
    for (int u = tid; u < (LDS_BYTES - LDSCTL_OFF) / 4; u += NTHR) ((LAS unsigned*)(lds + LDSCTL_OFF))[u] = 0u;
#endif
    __syncthreads();
#if defined(PROBE_P5) || defined(PROBE_P6) || defined(PROBE_PMM)
    if (blockIdx.x == 0 && tid == 0) __hip_atomic_store((unsigned*)ctl + 9064, 0xffffffffu, __ATOMIC_RELAXED, __HIP_MEMORY_SCOPE_AGENT);
#endif
    XcdBarrier bar; bar.bar = (unsigned*)(ctl + CW_BAR); bar.x = 0; bar.st = nullptr;
    const int lo = args.ph_lo, hi = args.ph_hi;
    if (hi - lo > 1) bar = xcd_barrier_post((unsigned*)(ctl + CW_BAR), MISC + 8);
#define IN(k) (lo <= (k) && (k) < hi)
#ifdef PROBE_EPI
#define PHID(k) do { if (blockIdx.x == 0 && tid == 0) MISC[24] = (k); } while (0)
#else
#define PHID(k) do { } while (0)
#endif
#define NEXTP(k) ((k) == 2 ? 4 : ((k) == 6 ? 8 : ((k) == 10 ? 12 : (k) + 1)))
#define BOTH(k) (IN(k) && IN(NEXTP(k)))
#define GRID_BAR(k) do { if (BOTH(k)) xcd_barrier(bar); TS(k); } while (0)
#ifdef PROBE_TSA
    if (blockIdx.x == 0 && tid == 0) { const unsigned long long t_ = rt(); MISC[16] = (unsigned)t_; MISC[17] = (unsigned)(t_ >> 32); }
#define TS(k) do { if (blockIdx.x == 0 && tid == 0) { const unsigned long long now_ = rt(); const unsigned long long prev_ = ((unsigned long long)MISC[17] << 32) | MISC[16]; \
        if ((k) == PROBE_TSA) MISC[20] = (unsigned)(now_ - prev_); if ((k) == PROBE_TSB) MISC[21] = (unsigned)(now_ - prev_); MISC[16] = (unsigned)now_; MISC[17] = (unsigned)(now_ >> 32); } } while (0)
#else
#define TS(k) do { } while (0)
#endif
    const int gw = blockIdx.x * NWAVES + wave, NGW = G * NWAVES;
    LAS float* scr = (LAS float*)(lds + RING_OFF + wave * 16384);
    bf16* XB = (bf16*)(ws + WS_XB);
    bf16* RXp = (bf16*)((unsigned char*)args.out + OUT_RX); bf16* RGp = (bf16*)((unsigned char*)args.out + OUT_RG);
    float* SS1 = (float*)(ws + WS_SS1); float* SS2 = (float*)(ws + WS_SS2);
    LAS float* part = (LAS float*)(lds + XTRA_OFF);

    if (IN(0)) {
        PHID(0);
        conv_all(args.in, ws, gw, NGW, scr, lane);
        rms_rows<false>(args.in[0], args.in[1], XB, gw, NGW, lane);
        GRID_BAR(0);
    }
    if (IN(1)) {
#ifdef PROBE_PMM
        if (PROBE_PMM == 1 && blockIdx.x == 0 && tid == 0) ((volatile unsigned*)ctl)[9128] = (unsigned)rt();
#endif
        PHID(1);
        pg8::Gemm g{XB, (const bf16*)(ws + WS_WGU), MTOK, NGU, DM}; pg8::StaticOrder S; S.init(MTOK, NGU, G, (int)blockIdx.x);
        EpiSwiGLU<false> E{(bf16*)(ws + WS_ACT), nullptr};
        pg8::gemm_phase<EpiSwiGLU<false>, pg8::StaticOrder, true, true>(lds + RING_OFF, g, S, E);
#ifdef PROBE_PMM
        if (PROBE_PMM == 1 && tid == 0) { const unsigned tnow = (unsigned)rt(); __hip_atomic_fetch_max((unsigned*)ctl + 9000, tnow, __ATOMIC_RELAXED, __HIP_MEMORY_SCOPE_AGENT); __hip_atomic_fetch_min((unsigned*)ctl + 9064, tnow, __ATOMIC_RELAXED, __HIP_MEMORY_SCOPE_AGENT); }
#endif
        GRID_BAR(1);
    }
    if (IN(2)) {
#ifdef PROBE_PMM
        if (PROBE_PMM == 2 && blockIdx.x == 0 && tid == 0) ((volatile unsigned*)ctl)[9128] = (unsigned)rt();
#endif
        PHID(2);
        pg8::Gemm g{(const bf16*)(ws + WS_ACT), (const bf16*)(ws + WS_WD), MTOK, DM, DFF}; pg8::StaticOrder S; S.init(MTOK, DM, G, (int)blockIdx.x);
        EpiResidB<true> E{args.in[0], XB, 0.5f, SS1, part};
        pg8::gemm_phase<EpiResidB<true>, pg8::StaticOrder, true, true>(lds + RING_OFF, g, S, E);
#ifdef PROBE_PMM
        if (PROBE_PMM == 2 && tid == 0) { const unsigned tnow = (unsigned)rt(); __hip_atomic_fetch_max((unsigned*)ctl + 9000, tnow, __ATOMIC_RELAXED, __HIP_MEMORY_SCOPE_AGENT); __hip_atomic_fetch_min((unsigned*)ctl + 9064, tnow, __ATOMIC_RELAXED, __HIP_MEMORY_SCOPE_AGENT); }
#endif
        GRID_BAR(2);
    }
    if (IN(4)) {
#ifdef PROBE_PMM
        if (PROBE_PMM == 4 && blockIdx.x == 0 && tid == 0) ((volatile unsigned*)ctl)[9128] = (unsigned)rt();
#endif
        PHID(4);
        pg8::Gemm g{XB, (const bf16*)(ws + WS_WA), MTOK, NAB, DM}; pg8::StaticOrder S; S.init(MTOK, NAB, G, (int)blockIdx.x);
        EpiProjA E{ws, RXp, RGp, SS1};
        pg8::gemm_phase<EpiProjA, pg8::StaticOrder, true, true>(lds + RING_OFF, g, S, E);
        for (int u = blockIdx.x; u < MTOK / 64; u += G) ikiw_unit(ws, lds, u, tid);
#ifdef PROBE_PMM
        if (PROBE_PMM == 4 && tid == 0) { const unsigned tnow = (unsigned)rt(); __hip_atomic_fetch_max((unsigned*)ctl + 9000, tnow, __ATOMIC_RELAXED, __HIP_MEMORY_SCOPE_AGENT); __hip_atomic_fetch_min((unsigned*)ctl + 9064, tnow, __ATOMIC_RELAXED, __HIP_MEMORY_SCOPE_AGENT); }
#endif
        GRID_BAR(4);
    }
    if (IN(5)) {
        PHID(5);
#ifdef PROBE_P5
        if (blockIdx.x == 0 && tid == 0) ((volatile unsigned*)ctl)[9128] = (unsigned)rt();
#endif
        for (int u = blockIdx.x; u < 256; u += G) rnn_unit(args.in, ws, RXp, RGp, lds, u, tid);
#ifdef PROBE_P5
        if (tid == 0) { const unsigned tnow = (unsigned)rt(); __hip_atomic_fetch_max((unsigned*)ctl + 9000, tnow, __ATOMIC_RELAXED, __HIP_MEMORY_SCOPE_AGENT); __hip_atomic_fetch_min((unsigned*)ctl + 9064, tnow, __ATOMIC_RELAXED, __HIP_MEMORY_SCOPE_AGENT); }
#endif
        {
            if (tid == 0) MISC[12] = __hip_atomic_fetch_add((unsigned*)ctl + 64, 1u, __ATOMIC_RELAXED, __HIP_MEMORY_SCOPE_AGENT);
            __syncthreads();
            unsigned item = MISC[12];
            for (int sl_ = 1; item < 1024u; sl_ ^= 1) {
                unsigned nxt_ = 0u;
                if (tid == 0) nxt_ = __hip_atomic_fetch_add((unsigned*)ctl + 64, 1u, __ATOMIC_RELAXED, __HIP_MEMORY_SCOPE_AGENT);
                const int qb = 127 - (int)(item >> 3), b = (int)(item & 7u);
                idx_scores(ws, lds, b, qb, tid); idx_select(ws, lds, b, qb, tid);
                if (tid == 0) MISC[12 + sl_] = nxt_;
                __syncthreads();
                item = MISC[12 + sl_];
            }
        }
        GRID_BAR(5);
    }
    if (IN(6)) {
        PHID(6);
#ifdef PROBE_P6
        if (blockIdx.x == 0 && tid == 0) ((volatile unsigned*)ctl)[9128] = (unsigned)rt();
#endif
        {
            if (tid == 0) MISC[12] = __hip_atomic_fetch_add((unsigned*)ctl + 128, 1u, __ATOMIC_RELAXED, __HIP_MEMORY_SCOPE_AGENT);
            __syncthreads();
            unsigned item = MISC[12];
            for (int sl_ = 1; item < 1024u; sl_ ^= 1) {
                unsigned nxt_ = 0u;
                if (tid == 0) nxt_ = __hip_atomic_fetch_add((unsigned*)ctl + 128, 1u, __ATOMIC_RELAXED, __HIP_MEMORY_SCOPE_AGENT);
                attn_item(args.in[14], ws, lds, (int)(item & 7u), (int)((item >> 3) & 3u), 31 - (int)(item >> 5), tid);
                if (tid == 0) MISC[12 + sl_] = nxt_;
                __syncthreads();
                item = MISC[12 + sl_];
            }
        }
#ifdef PROBE_P6
        if (tid == 0) { const unsigned tnow = (unsigned)rt(); __hip_atomic_fetch_max((unsigned*)ctl + 9000, tnow, __ATOMIC_RELAXED, __HIP_MEMORY_SCOPE_AGENT); __hip_atomic_fetch_min((unsigned*)ctl + 9064, tnow, __ATOMIC_RELAXED, __HIP_MEMORY_SCOPE_AGENT); }
#endif
        GRID_BAR(6);
    }
    if (IN(8)) {
        PHID(8);
        pg8::Gemm g{RGp, (const bf16*)(ws + WS_WPR), MTOK, DM, DM}; pg8::StaticOrder S; S.init(MTOK, DM, G, (int)blockIdx.x);
        EpiGateMul<false> E{(const bf16*)(ws + WS_SGR), (bf16*)(ws + WS_SGR)};
        pg8::gemm_phase<EpiGateMul<false>, pg8::StaticOrder, true, true>(lds + RING_OFF, g, S, E);
        GRID_BAR(8);
    }
    if (IN(9)) {
        PHID(9);
        pg8::Gemm g{(const bf16*)(ws + WS_Q), (const bf16*)(ws + WS_WPA), MTOK, DM, DM}; pg8::StaticOrder S; S.init(MTOK, DM, G, (int)blockIdx.x);
        EpiGateMul<true> E{(const bf16*)(ws + WS_SGA), (bf16*)(ws + WS_SGR)};
        pg8::gemm_phase<EpiGateMul<true>, pg8::StaticOrder, true, true>(lds + RING_OFF, g, S, E);
        GRID_BAR(9);
    }
    if (IN(10)) {
        PHID(10);
        pg8::Gemm g{(const bf16*)(ws + WS_SGR), (const bf16*)(ws + WS_WOUT), MTOK, DM, DM}; pg8::StaticOrder S; S.init(MTOK, DM, G, (int)blockIdx.x);
        EpiResidB<false> E{nullptr, XB, 1.0f, SS2, part};
        pg8::gemm_phase<EpiResidB<false>, pg8::StaticOrder, true, true>(lds + RING_OFF, g, S, E);
        GRID_BAR(10);
    }
    if (IN(12)) {
#ifdef PROBE_PMM
        if (PROBE_PMM == 12 && blockIdx.x == 0 && tid == 0) ((volatile unsigned*)ctl)[9128] = (unsigned)rt();
#endif
        PHID(12);
        pg8::Gemm g{XB, (const bf16*)(ws + WS_WGU2), MTOK, NGU, DM}; pg8::StaticOrder S; S.init(MTOK, NGU, G, (int)blockIdx.x);
        EpiSwiGLU<true> E{(bf16*)(ws + WS_ACT), SS2};
        pg8::gemm_phase<EpiSwiGLU<true>, pg8::StaticOrder, true, true>(lds + RING_OFF, g, S, E);
#ifdef PROBE_PMM
        if (PROBE_PMM == 12 && tid == 0) { const unsigned tnow = (unsigned)rt(); __hip_atomic_fetch_max((unsigned*)ctl + 9000, tnow, __ATOMIC_RELAXED, __HIP_MEMORY_SCOPE_AGENT); __hip_atomic_fetch_min((unsigned*)ctl + 9064, tnow, __ATOMIC_RELAXED, __HIP_MEMORY_SCOPE_AGENT); }
#endif
        GRID_BAR(12);
    }
    if (IN(13)) {
        PHID(13);
        pg8::Gemm g{(const bf16*)(ws + WS_ACT), (const bf16*)(ws + WS_WD2), MTOK, DM, DFF}; pg8::StaticOrder S; S.init(MTOK, DM, G, (int)blockIdx.x);
        EpiResidB<false> E{nullptr, XB, 0.5f, SS1, part};
        pg8::gemm_phase<EpiResidB<false>, pg8::StaticOrder, true, true>(lds + RING_OFF, g, S, E);
        GRID_BAR(13);
    }
    if (IN(14)) {
        PHID(14);
        rms_out_rows(XB, SS1, args.in[22], args.out, gw, NGW, lane);
#ifdef PROBE_TSA
        TS(14);
#if defined(PROBE_ATT) || defined(PROBE_RNN) || defined(PROBE_IDX)
        if (blockIdx.x == 0 && tid == 0) { const unsigned dA = MISC[40 + PROBE_ATT_A], dB = MISC[40 + PROBE_ATT_B];
#elif defined(PROBE_P5) || defined(PROBE_P6) || defined(PROBE_PMM)
        if (blockIdx.x == 0 && tid == 0) { const unsigned t0p = ((volatile unsigned*)ctl)[9128];
            const unsigned dA = __hip_atomic_load((unsigned*)ctl + 9064, __ATOMIC_RELAXED, __HIP_MEMORY_SCOPE_AGENT) - t0p, dB = __hip_atomic_load((unsigned*)ctl + 9000, __ATOMIC_RELAXED, __HIP_MEMORY_SCOPE_AGENT) - t0p;
#elif defined(PROBE_EPI)
        if (blockIdx.x == 0 && tid == 0) { const unsigned dA = MISC[23] * 1000u, dB = MISC[22];
#else
        if (blockIdx.x == 0 && tid == 0) { const unsigned dA = MISC[20], dB = MISC[21];
#endif
            args.out[0] += 1.0f + (float)dA * 0.001f;
            const unsigned long long t0_ = rt(), w_ = 8ull * dB; while (rt() - t0_ < w_) __builtin_amdgcn_s_sleep(8); }
#endif
    }
#undef IN
#undef BOTH
#undef NEXTP
#undef GRID_BAR
#undef TS
}


#if defined(PROBE_DIGEST) || defined(PROBE_P7)
__global__ void final3_k(const unsigned long long* D, float* out, size_t n) {
    const float c = (float)((D[0] != D[1] ? 1 : 0) + (D[1] != D[2] ? 2 : 0));
    for (size_t i = (size_t)blockIdx.x * blockDim.x + threadIdx.x; i < n; i += (size_t)gridDim.x * blockDim.x) out[i] = c;
}
__global__ void digest_k(const v4u* p, size_t n16, const v4u* q, size_t m16, unsigned long long* slot) {
    unsigned long long s = 0ull;
    for (size_t i = (size_t)blockIdx.x * blockDim.x + threadIdx.x; i < n16 + m16; i += (size_t)gridDim.x * blockDim.x) {
        const v4u x = i < n16 ? p[i] : q[i - n16];
        const unsigned long long h = (unsigned long long)i * 0x9E3779B97F4A7C15ull + 0x1234567ull;
        s += ((unsigned long long)x.x * 3ull + (unsigned long long)x.y * 5ull + (unsigned long long)x.z * 7ull + (unsigned long long)x.w * 11ull) * (h | 1ull);
    }
    for (int o = 32; o >= 1; o >>= 1) s += __shfl_xor(s, o);
    if ((threadIdx.x & 63) == 0) atomicAdd(slot, s);
}
__global__ void final_k(const unsigned long long* A, const unsigned long long* B, float* out, size_t n) {
    int k = 0; for (int i = N_PHASES - 1; i >= 0; --i) if (A[i] != B[i]) k = i + 1;
    const float c = (float)k;
    for (size_t i = (size_t)blockIdx.x * blockDim.x + threadIdx.x; i < n; i += (size_t)gridDim.x * blockDim.x) out[i] = c;
}
#endif
extern "C" void kernel_launch(void* const* d_in, const int* in_sizes, int n_in, void* d_out, int out_size, void* d_ws, size_t ws_size, hipStream_t stream) {
    static int grid = 0;
    if (grid == 0) {
        if (n_in != 23 || in_sizes[0] != MTOK * DM || out_size != MTOK * DM || ws_size < WS_END) {
            fprintf(stderr, "kernel_launch: unexpected shapes (n_in %d, in0 %d, out %d, ws %zu); nothing launched\n", n_in, n_in > 0 ? in_sizes[0] : -1, out_size, ws_size); grid = -1; return; }
        int dev = 0, cus = 0, per_cu = 0;
        if (hipGetDevice(&dev) != hipSuccess || hipDeviceGetAttribute(&cus, hipDeviceAttributeMultiprocessorCount, dev) != hipSuccess) { grid = -1; return; }
        if (hipFuncSetAttribute((const void*)mk_fwd, hipFuncAttributeMaxDynamicSharedMemorySize, LDS_BYTES) != hipSuccess) { fprintf(stderr, "kernel_launch: hipFuncSetAttribute failed\n"); grid = -1; return; }
        if (hipOccupancyMaxActiveBlocksPerMultiprocessor(&per_cu, (const void*)mk_fwd, NTHR, LDS_BYTES) != hipSuccess || per_cu < 1)
            fprintf(stderr, "kernel_launch: note: occupancy query reports %d workgroups per CU\n", per_cu);
        (void)hipGetLastError();
        grid = cus;
    }
    if (grid < 0) return;
#ifdef PROBE_CLEAR
    if (hipMemsetAsync((char*)d_ws, 0, WS_END, stream) != hipSuccess) return;
    if (hipMemsetAsync((char*)d_out, 0, (size_t)MTOK * DM * 4, stream) != hipSuccess) return;
#else
    if (hipMemsetAsync((char*)d_ws + WS_CTL, 0, CTL_ZERO_BYTES, stream) != hipSuccess) return;
#endif
    Args a{};
    for (int i = 0; i < 23; ++i) a.in[i] = (const float*)d_in[i];
    a.out = (float*)d_out; a.ws = (unsigned char*)d_ws;
#ifdef PROBE_DIGEST
    unsigned long long* slots = (unsigned long long*)((char*)d_ws + WS_END);
    (void)hipMemsetAsync(slots, 0, 4096, stream);
    for (int run = 0; run < 2; ++run) {
        (void)hipMemsetAsync((char*)d_ws, 0, WS_END, stream);
        (void)hipMemsetAsync((char*)d_out, 0, (size_t)MTOK * DM * 4, stream);
        for (int k = 0; k < N_PHASES; ++k) { a.ph_lo = k; a.ph_hi = k + 1; hipLaunchKernelGGL(mk_fwd, dim3(grid), dim3(NTHR), LDS_BYTES, stream, a);
            hipLaunchKernelGGL(digest_k, dim3(2048), dim3(256), 0, stream, (const v4u*)((char*)d_ws + MiB), (size_t)(WS_END - MiB) / 16, (const v4u*)d_out, (size_t)MTOK * DM * 4 / 16, slots + run * 64 + k); }
    }
    hipLaunchKernelGGL(final_k, dim3(2048), dim3(256), 0, stream, slots, slots + 64, (float*)d_out, (size_t)MTOK * DM);
#elif defined(PROBE_P7)
    unsigned long long* slots = (unsigned long long*)((char*)d_ws + WS_END);
    (void)hipMemsetAsync(slots, 0, 4096, stream);
    (void)hipMemsetAsync((char*)d_ws, 0, WS_END, stream);
    (void)hipMemsetAsync((char*)d_out, 0, (size_t)MTOK * DM * 4, stream);
    for (int k = 0; k < 7; ++k) { a.ph_lo = k; a.ph_hi = k + 1; hipLaunchKernelGGL(mk_fwd, dim3(grid), dim3(NTHR), LDS_BYTES, stream, a); }
    for (int r = 0; r < 3; ++r) { a.ph_lo = 7; a.ph_hi = 8; hipLaunchKernelGGL(mk_fwd, dim3(grid), dim3(NTHR), LDS_BYTES, stream, a);
        hipLaunchKernelGGL(digest_k, dim3(2048), dim3(256), 0, stream, (const v4u*)((char*)d_ws + MiB), (size_t)(WS_END - MiB) / 16, (const v4u*)d_out, (size_t)MTOK * DM * 4 / 16, slots + r); }
    hipLaunchKernelGGL(final3_k, dim3(2048), dim3(256), 0, stream, slots, (float*)d_out, (size_t)MTOK * DM);
#elif MK_N_LAUNCHES == 1
    a.ph_lo = 0; a.ph_hi = N_PHASES;
    hipLaunchKernelGGL(mk_fwd, dim3(grid), dim3(NTHR), LDS_BYTES, stream, a);
#else
    for (int k = 0; k < N_PHASES; ++k) { a.ph_lo = k; a.ph_hi = k + 1; hipLaunchKernelGGL(mk_fwd, dim3(grid), dim3(NTHR), LDS_BYTES, stream, a); }
#endif
}
```

```cpp
#include <hip/hip_runtime.h>
#include <cstdio>
#include <cstdint>
#ifdef PROBE_EPI
#define PG8_HOOK_PRE() do { if (blockIdx.x == 0 && threadIdx.x == 0) { volatile __attribute__((address_space(3))) unsigned* M_ = (volatile __attribute__((address_space(3))) unsigned*)(163840 - 512 + 320); \
    if (M_[24] == PROBE_EPI) { asm volatile("s_waitcnt vmcnt(0)" ::: "memory"); M_[25] = (unsigned)__builtin_amdgcn_s_memrealtime(); } } } while (0)
#define PG8_HOOK_POST() do { if (blockIdx.x == 0 && threadIdx.x == 0) { volatile __attribute__((address_space(3))) unsigned* M_ = (volatile __attribute__((address_space(3))) unsigned*)(163840 - 512 + 320); \
    if (M_[24] == PROBE_EPI) { asm volatile("s_waitcnt vmcnt(0)" ::: "memory"); M_[22] += (unsigned)__builtin_amdgcn_s_memrealtime() - M_[25]; M_[23] += 1u; } } } while (0)
#else
#define PG8_HOOK_PRE() do { } while (0)
#define PG8_HOOK_POST() do { } while (0)
#endif
#define MK_N_LAUNCHES 1
namespace pg8 {
#define PG8_LAS __attribute__((address_space(3)))
typedef unsigned short bf16_t;
typedef short bf16x8 __attribute__((ext_vector_type(8)));
typedef float f32x4 __attribute__((ext_vector_type(4)));
typedef unsigned u32x4 __attribute__((ext_vector_type(4)));
constexpr int BM = 256, BK = 64, HALF = 128, HTB = HALF * BK * 2  , STAGE_BYTES = 8 * HTB, NXCD = 8, WGM = 8;

__host__ __device__ __forceinline__ int lds_byte(int r, int c) { const int st = (r >> 4) * 2 + (c >> 5), rr = r & 15, cc = c & 31, ob = rr * 64 + cc * 2; return st * 1024 + (ob ^ (((ob >> 9) & 1) << 5)); }
__host__ __device__ __forceinline__ void stage_rc(int b, int& R, int& C) { const int st = b / 1024, sb = b % 1024, swz = sb ^ (((sb >> 9) & 1) << 5); R = (st >> 1) * 16 + swz / 64; C = (st & 1) * 32 + (swz % 64) / 2; }
__host__ __device__ __forceinline__ int perm32(int rho) { const int n = rho >> 4, i = rho & 15; return 8 * (i >> 2) + 4 * n + (i & 3); }

struct Unit { int pm, pn; };
struct Gemm { const bf16_t* A; const bf16_t* Bt; int M, N, K; };

struct StaticOrder {
    int nM, nN, nwg, G, c, wgm;
    __host__ __device__ void init(int M, int N, int G_, int c_, int wgm_ = WGM) { nM = M / BM; nN = N / BM; nwg = nM * nN; G = G_; c = c_; wgm = wgm_; }
    __host__ __device__ bool next(int i, Unit& u) const {
        const long L = (long)i * G + c; if (L >= nwg) return false;
        int wgid = (int)L; { const int q = nwg / NXCD, r = nwg % NXCD, xcd = wgid % NXCD, off = wgid / NXCD; wgid = (xcd < r ? xcd * (q + 1) : r * (q + 1) + (xcd - r) * q) + off; }
        const int nig = wgm * nN, gid = wgid / nig, fm = gid * wgm, gsz = (nM - fm) < wgm ? (nM - fm) : wgm;
        u.pm = fm + ((wgid % nig) % gsz); u.pn = (wgid % nig) / gsz; return true;
    }
    __device__ __forceinline__ void a_ready(const Unit&) const {}
    __device__ __forceinline__ void done(const Unit&) const {}
};
__device__ __forceinline__ unsigned cvt_pk_bf16(float lo, float hi) { unsigned r; asm volatile("v_cvt_pk_bf16_f32 %0, %1, %2" : "=v"(r) : "v"(lo), "v"(hi)); return r; }
typedef float f32x2 __attribute__((ext_vector_type(2)));
template <class Epi, class Sched, bool ALIGN_EPI = false, bool SP2 = false>
__device__ __forceinline__ void gemm_phase(PG8_LAS unsigned char* lds, const Gemm g, const Sched& S, const Epi& E) {
    const int tid = threadIdx.x, wid = __builtin_amdgcn_readfirstlane(tid >> 6), lane = tid & 63, wr = wid >> 2, wc = wid & 3, fr = lane & 15, fq = lane >> 4;
    const int K = g.K, nt = K / BK;
    unsigned voffA[2], voffB[2];
#pragma unroll
    for (int i = 0; i < 2; ++i) { int R, C; stage_rc(tid * 16 + i * 8192, R, C); const int Rb = Epi::PERM ? ((R & ~31) + perm32(R & 31)) : R;
        voffA[i] = (unsigned)(R * K + C) * 2u; voffB[i] = (unsigned)(Rb * K + C) * 2u; }
    const size_t kstep = (size_t)(BK * 2);
    const size_t hstep = (size_t)HALF * K * 2;
    const size_t tstep = 2 * hstep;
    const unsigned ldsw = (unsigned)wid * 1024u;
    const int aoff = lds_byte(wr * 64 + fr, fq * 8), boff = lds_byte(wc * 32 + fr, fq * 8);
#define PG8_SA(b, h) (((b) * 2 + (h)) * HTB)
#define PG8_SB(b, h) ((4 + (b) * 2 + (h)) * HTB)
#define PG8_STAGE(bufoff, gbase, voff) do { _Pragma("unroll") for (int _i = 0; _i < 2; ++_i) \
        __builtin_amdgcn_global_load_lds((const unsigned*)((const char*)(gbase) + (voff)[_i]), (PG8_LAS unsigned*)(lds + (bufoff) + ldsw + _i * 8192), 16, 0, 0); } while (0)
#define PG8_LDA(dst, b, h) do { _Pragma("unroll") for (int m = 0; m < 4; ++m) _Pragma("unroll") for (int k = 0; k < 2; ++k) dst[m][k] = *(const PG8_LAS bf16x8*)(lds + PG8_SA(b, h) + aoff + m * 2048 + k * 1024); } while (0)
#define PG8_LDB(dst, b, h) do { _Pragma("unroll") for (int n = 0; n < 2; ++n) _Pragma("unroll") for (int k = 0; k < 2; ++k) dst[n][k] = *(const PG8_LAS bf16x8*)(lds + PG8_SB(b, h) + boff + n * 2048 + k * 1024); } while (0)
#define PG8_MMA(ai, bj, At, Bt) do { __builtin_amdgcn_s_setprio(1); _Pragma("unroll") for (int m = 0; m < 4; ++m) _Pragma("unroll") for (int n = 0; n < 2; ++n) _Pragma("unroll") for (int k = 0; k < 2; ++k) \
        acc[ai][bj][m][n] = __builtin_amdgcn_mfma_f32_16x16x32_bf16(Bt[n][k], At[m][k], acc[ai][bj][m][n], 0, 0, 0); __builtin_amdgcn_s_setprio(0); } while (0)
#define PG8_WAIT_V(n) asm volatile("s_waitcnt vmcnt(" #n ")" ::: "memory")
#define PG8_WAIT_L(n) asm volatile("s_waitcnt lgkmcnt(" #n ")" ::: "memory")
#define PG8_BAR __builtin_amdgcn_s_barrier()
#define PG8_SCHED __builtin_amdgcn_sched_barrier(0)
    Unit cur, nxt; int ui = 0;
    if (!S.next(0, cur)) return;
    f32x4 acc[2][2][4][2];
#pragma unroll
    for (int a = 0; a < 2; ++a)
#pragma unroll
        for (int b = 0; b < 2; ++b)
#pragma unroll
            for (int m = 0; m < 4; ++m)
#pragma unroll
                for (int n = 0; n < 2; ++n) acc[a][b][m][n] = (f32x4){0.f, 0.f, 0.f, 0.f};
    bf16x8 At[4][2], B0[2][2], B1[2][2];
    const char* cA = (const char*)g.A + (size_t)cur.pm * tstep; const char* cB = (const char*)g.Bt + (size_t)cur.pn * tstep;
    S.a_ready(cur);
    if constexpr (SP2) {
        PG8_STAGE(PG8_SB(0, 0), cB, voffB); PG8_STAGE(PG8_SB(0, 1), cB + hstep, voffB); PG8_STAGE(PG8_SA(0, 0), cA, voffA); PG8_STAGE(PG8_SA(0, 1), cA + hstep, voffA);
        if (wr == 1) PG8_BAR;
        PG8_WAIT_V(2); PG8_BAR;
        PG8_STAGE(PG8_SB(1, 0), cB + kstep, voffB); PG8_STAGE(PG8_SA(1, 0), cA + kstep, voffA); PG8_STAGE(PG8_SB(1, 1), cB + hstep + kstep, voffB);
        PG8_WAIT_V(6); PG8_BAR;
    } else {
        PG8_STAGE(PG8_SB(0, 0), cB, voffB); PG8_STAGE(PG8_SA(0, 0), cA, voffA); PG8_STAGE(PG8_SB(0, 1), cB + hstep, voffB); PG8_STAGE(PG8_SA(0, 1), cA + hstep, voffA);
        if (wr == 1) PG8_BAR;
        PG8_WAIT_V(4); PG8_BAR;
        PG8_STAGE(PG8_SB(1, 0), cB + kstep, voffB); PG8_STAGE(PG8_SA(1, 0), cA + kstep, voffA); PG8_STAGE(PG8_SB(1, 1), cB + hstep + kstep, voffB);
        PG8_WAIT_V(6); PG8_BAR;
    }
    for (;;) {
        const bool has_next = S.next(ui + 1, nxt);
        const char* nA = has_next ? (const char*)g.A + (size_t)nxt.pm * tstep : cA; const char* nB = has_next ? (const char*)g.Bt + (size_t)nxt.pn * tstep : cB;
        for (int t = 0; t < nt; t += 2) {
            const bool last = (t == nt - 2);
            const char* a1 = cA + (size_t)(t + 1) * kstep;
            const char* a2 = last ? nA : cA + (size_t)(t + 2) * kstep; const char* b2 = last ? nB : cB + (size_t)(t + 2) * kstep;
            const char* a3 = a2 + kstep; const char* b3 = b2 + kstep;
            if (last && has_next) S.a_ready(nxt);
            if constexpr (SP2) {
            PG8_LDB(B0, 0, 0); PG8_LDB(B1, 0, 1); PG8_SCHED; PG8_LDA(At, 0, 0); PG8_STAGE(PG8_SA(1, 1), a1 + hstep, voffA);
            PG8_WAIT_V(8); PG8_WAIT_L(0); PG8_BAR; PG8_MMA(0, 0, At, B0); PG8_MMA(0, 1, At, B1); PG8_BAR; PG8_SCHED;
            PG8_LDA(At, 0, 1); PG8_STAGE(PG8_SB(0, 0), b2, voffB); PG8_STAGE(PG8_SB(0, 1), b2 + hstep, voffB); PG8_STAGE(PG8_SA(0, 0), a2, voffA);
            PG8_WAIT_V(8); PG8_WAIT_L(0); PG8_BAR; PG8_MMA(1, 0, At, B0); PG8_MMA(1, 1, At, B1); PG8_BAR; PG8_SCHED;
            PG8_LDB(B0, 1, 0); PG8_LDB(B1, 1, 1); PG8_SCHED; PG8_LDA(At, 1, 0); PG8_STAGE(PG8_SA(0, 1), a2 + hstep, voffA);
            PG8_WAIT_V(8); PG8_WAIT_L(0); PG8_BAR; PG8_MMA(0, 0, At, B0); PG8_MMA(0, 1, At, B1); PG8_BAR; PG8_SCHED;
            PG8_LDA(At, 1, 1); PG8_STAGE(PG8_SB(1, 0), b3, voffB); PG8_STAGE(PG8_SB(1, 1), b3 + hstep, voffB); PG8_STAGE(PG8_SA(1, 0), a3, voffA);
            PG8_WAIT_V(8); PG8_WAIT_L(0); PG8_BAR; PG8_MMA(1, 0, At, B0); PG8_MMA(1, 1, At, B1); PG8_BAR; PG8_SCHED;
            } else {
            PG8_LDB(B0, 0, 0); PG8_SCHED; PG8_LDA(At, 0, 0); PG8_STAGE(PG8_SA(1, 1), a1 + hstep, voffA);
            PG8_WAIT_L(8); PG8_BAR; PG8_WAIT_L(0); PG8_MMA(0, 0, At, B0); PG8_BAR; PG8_SCHED;
            PG8_LDB(B1, 0, 1); PG8_STAGE(PG8_SB(0, 0), b2, voffB);
            PG8_BAR; PG8_WAIT_L(0); PG8_MMA(0, 1, At, B1); PG8_BAR;
            PG8_LDA(At, 0, 1); PG8_STAGE(PG8_SA(0, 0), a2, voffA);
            PG8_BAR; PG8_WAIT_L(0); PG8_MMA(1, 0, At, B0); PG8_BAR; PG8_SCHED;
            PG8_STAGE(PG8_SB(0, 1), b2 + hstep, voffB);
            PG8_WAIT_V(6); PG8_BAR; PG8_MMA(1, 1, At, B1); PG8_BAR;
            PG8_LDB(B0, 1, 0); PG8_SCHED; PG8_LDA(At, 1, 0); PG8_STAGE(PG8_SA(0, 1), a2 + hstep, voffA);
            PG8_WAIT_L(8); PG8_BAR; PG8_WAIT_L(0); PG8_MMA(0, 0, At, B0); PG8_BAR; PG8_SCHED;
            PG8_LDB(B1, 1, 1); PG8_STAGE(PG8_SB(1, 0), b3, voffB);
            PG8_BAR; PG8_WAIT_L(0); PG8_MMA(0, 1, At, B1); PG8_BAR;
            PG8_LDA(At, 1, 1); PG8_STAGE(PG8_SA(1, 0), a3, voffA);
            PG8_BAR; PG8_WAIT_L(0); PG8_MMA(1, 0, At, B0); PG8_BAR; PG8_SCHED;
            PG8_STAGE(PG8_SB(1, 1), b3 + hstep, voffB);
            PG8_WAIT_V(6); PG8_BAR; PG8_MMA(1, 1, At, B1); PG8_BAR;
            }
        }
        if constexpr (ALIGN_EPI) { if (wr == 0) PG8_BAR; }
        PG8_HOOK_PRE(); if constexpr (!Epi::AFTER_DRAIN) { E(acc, cur, wr, wc, fr, fq); S.done(cur); } PG8_HOOK_POST();
        if (!has_next) break;
#pragma unroll
        for (int a = 0; a < 2; ++a)
#pragma unroll
            for (int b = 0; b < 2; ++b)
#pragma unroll
                for (int m = 0; m < 4; ++m)
#pragma unroll
                    for (int n = 0; n < 2; ++n) acc[a][b][m][n] = (f32x4){0.f, 0.f, 0.f, 0.f};
        cur = nxt; cA = nA; cB = nB; ++ui;
        if constexpr (ALIGN_EPI) { if (wr == 1) PG8_BAR; }
    }
    PG8_WAIT_V(0);
    if constexpr (!ALIGN_EPI) { if (wr == 0) PG8_BAR; }
    PG8_BAR;
    if constexpr (Epi::AFTER_DRAIN) { E.fused(acc, cur, wr, wc, fr, fq, lds, wid, lane); S.done(cur); }
#undef PG8_SA
#undef PG8_SB
#undef PG8_STAGE
#undef PG8_LDA
#undef PG8_LDB
#undef PG8_MMA
#undef PG8_WAIT_V
#undef PG8_WAIT_L
#undef PG8_BAR
#undef PG8_SCHED
}
}

constexpr int NWAVES = 8, NTHR = 512;
constexpr int BATCH = 8, SEQ = 2048, DM = 2048, MTOK = BATCH * SEQ, DFF = 5504, NGU = 2 * DFF;
constexpr int NIN = 12368, NA = 8192, NIKW = 80, NB = 4096, NAB = NA + NB;
constexpr int KVW = 512, IQW = 1024;
constexpr float RMS_EPS = 1e-6f;
constexpr float LOG2E = 1.4426950408889634f;

constexpr size_t MiB = 1u << 20;
constexpr size_t WS_CTL = 0, CTL_ZERO_BYTES = 1 * MiB;
constexpr size_t WS_WGU = 2 * MiB;
constexpr size_t WS_WD = 45 * MiB;
constexpr size_t WS_WGU2 = 67 * MiB, WS_WD2 = 110 * MiB;
constexpr size_t WS_WA = 132 * MiB;
constexpr size_t WS_WB = 164 * MiB;
constexpr size_t WS_WPR = 180 * MiB, WS_WPA = 188 * MiB, WS_WOUT = 196 * MiB;
constexpr size_t WS_RGA = 204 * MiB, WS_RGX = WS_RGA + MiB / 2;
constexpr size_t WS_WIKT = 205 * MiB;
constexpr size_t WS_XB = 206 * MiB;
constexpr size_t WS_ACT = 270 * MiB;
constexpr size_t WS_Q = 270 * MiB;
constexpr size_t WS_K = 334 * MiB;
constexpr size_t WS_VT = 350 * MiB;
constexpr size_t WS_IQ = 366 * MiB;
constexpr size_t WS_IK = 398 * MiB;
constexpr size_t WS_IW = 400 * MiB;
constexpr size_t WS_MASK = 402 * MiB;
constexpr size_t WS_SS1 = 205 * MiB + MiB / 2, WS_SS2 = 1 * MiB;
constexpr size_t WS_SGR = 406 * MiB;
constexpr size_t WS_SGA = 2 * MiB;
constexpr size_t WS_END = 470 * MiB;
constexpr size_t OUT_RX = 0, OUT_RG = 64 * MiB;
static_assert(WS_ACT + (size_t)MTOK * DFF * 2 == 442 * MiB && WS_WGU + (size_t)NGU * DM * 2 == WS_WD && WS_WD + (size_t)DM * DFF * 2 <= WS_WGU2 && WS_WGU2 + (size_t)NGU * DM * 2 == WS_WD2, "map");
constexpr int CW_BAR = 4096;

constexpr int RING_OFF = 0, RING_BYTES = 131072;
constexpr int LDS_BYTES = 163840;
constexpr int XTRA_OFF = 131072;
constexpr int LDSCTL_OFF = LDS_BYTES - 512, MISC_OFF = LDSCTL_OFF + 320;
#define GAS __attribute__((address_space(1)))
#define LAS __attribute__((address_space(3)))
typedef unsigned short bf16;
typedef unsigned v4u __attribute__((ext_vector_type(4)));
typedef float f32x4 __attribute__((ext_vector_type(4)));
typedef short bf16x8 __attribute__((ext_vector_type(8)));
typedef GAS unsigned gu32;
typedef GAS unsigned long long gu64;
#define RLX_AGENT __ATOMIC_RELAXED, __HIP_MEMORY_SCOPE_AGENT
#define LDS_WAIT() asm volatile("s_waitcnt lgkmcnt(0)" ::: "memory")
#define VM_WAIT() asm volatile("s_waitcnt vmcnt(0)" ::: "memory")
__device__ __forceinline__ unsigned long long rt() { return __builtin_amdgcn_s_memrealtime(); }
__device__ __forceinline__ unsigned f2bf(float f) { unsigned u = __builtin_bit_cast(unsigned, f); return (u + 0x7fffu + ((u >> 16) & 1u)) >> 16; }
__device__ __forceinline__ unsigned pk2(float lo, float hi) { return f2bf(lo) | (f2bf(hi) << 16); }

#define XB_TMO      128
#define XB_XCNT(j)  (256  + 64 * (j))
#define XB_XSUB(j)  (1280 + 64 * (j))
#define XB_XGEN(j)  (2304 + 64 * (j))
#define XB_TOP      3328
#define XB_TOPGEN   3392
#define XCD_BAR_WORDS 3456
#define XB_SPIN_CAP (1u << 18)

__device__ __forceinline__ unsigned xb_ld(unsigned* p)              { return __hip_atomic_load(p, __ATOMIC_RELAXED, __HIP_MEMORY_SCOPE_AGENT); }
__device__ __forceinline__ unsigned xb_add(unsigned* p, unsigned v) { return __hip_atomic_fetch_add(p, v, __ATOMIC_RELAXED, __HIP_MEMORY_SCOPE_AGENT); }
__device__ __forceinline__ unsigned xb_xcc_id() { return (unsigned)__builtin_amdgcn_s_getreg((3 << 11) | 20) & 0xFu; }
#define XB_SPIN(cond, bar) do { unsigned _sp = 0; while (cond) { __builtin_amdgcn_s_sleep(1); \
    if ((++_sp & 255u) == 0u) { if (xb_ld(&(bar)[XB_TMO])) break; if (_sp > XB_SPIN_CAP) { atomicAdd(&(bar)[XB_TMO], 1u); break; } } } } while (0)

struct XcdBarrier {
    unsigned* bar; unsigned x;
    volatile LAS unsigned* st;
};

__device__ __forceinline__ XcdBarrier xcd_barrier_post(unsigned* bar, volatile LAS unsigned* st) {
    XcdBarrier b; b.bar = bar; b.x = xb_xcc_id(); b.st = st;
    if (threadIdx.x == 0) (void)xb_add(&bar[XB_XCNT(b.x)], 1u);
    return b;
}
__device__ __forceinline__ void xcd_barrier_complete(unsigned* bar, unsigned x, unsigned& nloc, unsigned& nx) {
    const unsigned G = gridDim.x * gridDim.y * gridDim.z;
    unsigned sum, cnt, mine, sp = 0u;
    for (;;) {
        sum = 0u; cnt = 0u; mine = 0u;
#pragma unroll
        for (unsigned j = 0; j < 16; ++j) { const unsigned c = xb_ld(&bar[XB_XCNT(j)]); sum += c; cnt += (c > 0u) ? 1u : 0u; mine = (j == x) ? c : mine; }
        if (sum == G) break;
        __builtin_amdgcn_s_sleep(1);
        if ((++sp & 255u) == 0u) { if (xb_ld(&bar[XB_TMO])) break; if (sp > XB_SPIN_CAP) { atomicAdd(&bar[XB_TMO], 1u); break; } }
    }
    nloc = mine > 0u ? mine : 1u; nx = cnt > 0u ? cnt : 1u;
}

__device__ __forceinline__ void xcd_barrier(const XcdBarrier& b) {
    asm volatile("s_waitcnt vmcnt(0)" ::: "memory");
    __syncthreads();
    if (threadIdx.x == 0) {
        unsigned* bar = b.bar;
        __builtin_amdgcn_s_waitcnt(0);
        unsigned nloc = b.st[0], nx = b.st[1];
        if (nloc == 0u) { xcd_barrier_complete(bar, b.x, nloc, nx); b.st[0] = nloc; b.st[1] = nx; }
        const unsigned old = xb_add(&bar[XB_XSUB(b.x)], 1u);
        const unsigned gen = old / nloc;
        if (old + 1u == (gen + 1u) * nloc) {
            __builtin_amdgcn_fence(__ATOMIC_RELEASE, "agent");
            asm volatile("s_waitcnt vmcnt(0)" ::: "memory");
            const unsigned og = xb_add(&bar[XB_TOP], 1u);
            const unsigned tg = og / nx;
            if (og + 1u == (tg + 1u) * nx) xb_add(&bar[XB_TOPGEN], 1u);
            else XB_SPIN(xb_ld(&bar[XB_TOPGEN]) == tg, bar);
            __builtin_amdgcn_fence(__ATOMIC_ACQUIRE, "agent");
            xb_add(&bar[XB_XGEN(b.x)], 1u);
            asm volatile("s_waitcnt vmcnt(0)" ::: "memory");
        } else {
            XB_SPIN(xb_ld(&bar[XB_XGEN(b.x)]) == gen, bar);
            __builtin_amdgcn_fence(__ATOMIC_ACQUIRE, "agent");
            asm volatile("s_waitcnt vmcnt(0)" ::: "memory");
        }
    }
    __syncthreads();
}

__device__ __forceinline__ void xcd_barrier_local(const XcdBarrier& b) {
    asm volatile("s_waitcnt vmcnt(0)" ::: "memory");
    __syncthreads();
    if (threadIdx.x == 0) {
        unsigned* bar = b.bar;
        __builtin_amdgcn_s_waitcnt(0);
        const unsigned nloc = b.st[0];
        const unsigned old = xb_add(&bar[XB_XSUB(b.x)], 1u);
        const unsigned gen = old / nloc;
        if (old + 1u == (gen + 1u) * nloc) xb_add(&bar[XB_XGEN(b.x)], 1u);
        else XB_SPIN(xb_ld(&bar[XB_XGEN(b.x)]) == gen, bar);
        __builtin_amdgcn_fence(__ATOMIC_ACQUIRE, "agent");
        asm volatile("s_waitcnt vmcnt(0)" ::: "memory");
    }
    __syncthreads();
}

typedef float f32x16 __attribute__((ext_vector_type(16)));
typedef short s16x4 __attribute__((ext_vector_type(4)));
typedef unsigned v2u __attribute__((ext_vector_type(2)));

__device__ __forceinline__ float bf2f(unsigned short h) { return __builtin_bit_cast(float, (unsigned)h << 16); }
__device__ __forceinline__ float fast_exp2(float x) { return __builtin_amdgcn_exp2f(x); }
__device__ __forceinline__ float fast_rcp(float x) { return __builtin_amdgcn_rcpf(x); }
__device__ __forceinline__ float sigmoidf_(float x) { return fast_rcp(1.0f + fast_exp2(-x * LOG2E)); }
__device__ __forceinline__ float siluf_(float x) { return x * sigmoidf_(x); }
__device__ __forceinline__ float gelu_tanh(float x) { const float u = 0.7978845608028654f * (x + 0.044715f * x * x * x); return x * sigmoidf_(2.0f * u); }
typedef __bf16 bf16x2_t __attribute__((ext_vector_type(2)));
typedef float f32x2_t __attribute__((ext_vector_type(2)));
__device__ __forceinline__ unsigned cvtpk(float lo, float hi) { const f32x2_t v = {lo, hi}; const bf16x2_t b = __builtin_convertvector(v, bf16x2_t); return __builtin_bit_cast(unsigned, b); }
__device__ __forceinline__ float wave_sum(float v) {
#pragma unroll
    for (int o = 1; o < 64; o <<= 1) v += __shfl_xor(v, o);
    return v;
}

typedef pg8::f32x4 pf4;
typedef pg8::u32x4 pu4;
__device__ __forceinline__ float bfl(unsigned w) { return __builtin_bit_cast(float, w << 16); }
__device__ __forceinline__ float bfh(unsigned w) { return __builtin_bit_cast(float, w & 0xffff0000u); }
__device__ __forceinline__ void load_rstd(const float* ss, int row0, float (&rs)[2][4]) {
#pragma unroll
    for (int ai = 0; ai < 2; ++ai)
#pragma unroll
        for (int m = 0; m < 4; ++m) {
            const pf4* p = (const pf4*)(ss + (size_t)(row0 + ai * 128 + m * 16) * 8); const pf4 a = p[0], b = p[1];
            const float s = ((a[0] + a[1]) + (a[2] + a[3])) + ((b[0] + b[1]) + (b[2] + b[3]));
            rs[ai][m] = __builtin_amdgcn_rsqf(s * (1.0f / DM) + RMS_EPS);
        }
}
template <bool SCALE> struct EpiSwiGLU {
    static constexpr bool PERM = true, AFTER_DRAIN = false;
    bf16* O; const float* ss;
    __device__ __forceinline__ void operator()(const pf4 (&acc)[2][2][4][2], const pg8::Unit& u, int wr, int wc, int fr, int fq) const {
        const int row0 = u.pm * 256 + wr * 64 + fr, col = u.pn * 128 + wc * 32 + 8 * fq;
        float rs[2][4];
        if (SCALE) load_rstd(ss, row0, rs);
#pragma unroll
        for (int ai = 0; ai < 2; ++ai)
#pragma unroll
            for (int m = 0; m < 4; ++m) {
                bf16* rowp = O + (size_t)(row0 + ai * 128 + m * 16) * DFF + col;
                pf4 g0 = acc[ai][0][m][0], g1 = acc[ai][0][m][1], u0 = acc[ai][1][m][0], u1 = acc[ai][1][m][1];
                if (SCALE) { const float r = rs[ai][m]; g0 *= r; g1 *= r; u0 *= r; u1 *= r; }
                pu4 w;
                w.x = cvtpk(siluf_(g0[0]) * u0[0], siluf_(g0[1]) * u0[1]); w.y = cvtpk(siluf_(g0[2]) * u0[2], siluf_(g0[3]) * u0[3]);
                w.z = cvtpk(siluf_(g1[0]) * u1[0], siluf_(g1[1]) * u1[1]); w.w = cvtpk(siluf_(g1[2]) * u1[2], siluf_(g1[3]) * u1[3]);
                *(pu4*)rowp = w;
            }
    }
};
template <bool F32BASE> struct EpiResidB {
    static constexpr bool PERM = true, AFTER_DRAIN = false;
    const float* basef; bf16* xb; float alpha; float* ss; LAS float* part;
    __device__ __forceinline__ void operator()(const pf4 (&acc)[2][2][4][2], const pg8::Unit& u, int wr, int wc, int fr, int fq) const {
        const int row0 = u.pm * 256 + wr * 64 + fr, col = u.pn * 256 + wc * 32 + 8 * fq;
#pragma unroll
        for (int ai = 0; ai < 2; ++ai)
#pragma unroll
            for (int m = 0; m < 4; ++m) {
                float sq = 0.f;
#pragma unroll
                for (int bj = 0; bj < 2; ++bj) {
                    const size_t ro = (size_t)(row0 + ai * 128 + m * 16) * DM + col + bj * 128;
                    float b[8];
                    if (F32BASE) { const pf4 b0 = *(const pf4*)(basef + ro), b1 = *(const pf4*)(basef + ro + 4);
#pragma unroll
                        for (int j = 0; j < 4; ++j) { b[j] = b0[j]; b[4 + j] = b1[j]; } }
                    else { const pu4 bw = *(const pu4*)(xb + ro);
#pragma unroll
                        for (int j = 0; j < 4; ++j) { b[2 * j] = bfl(bw[j]); b[2 * j + 1] = bfh(bw[j]); } }
                    const pf4 v0 = acc[ai][bj][m][0], v1 = acc[ai][bj][m][1];
                    pu4 w;
                    w.x = cvtpk(b[0] + alpha * v0[0], b[1] + alpha * v0[1]); w.y = cvtpk(b[2] + alpha * v0[2], b[3] + alpha * v0[3]);
                    w.z = cvtpk(b[4] + alpha * v1[0], b[5] + alpha * v1[1]); w.w = cvtpk(b[6] + alpha * v1[2], b[7] + alpha * v1[3]);
                    *(pu4*)(xb + ro) = w;
#pragma unroll
                    for (int j = 0; j < 4; ++j) { const float lo = bfl(w[j]), hi = bfh(w[j]); sq += lo * lo + hi * hi; }
                }
                sq += __shfl_xor(sq, 16); sq += __shfl_xor(sq, 32);
                if (fq == 0) part[(ai * 128 + wr * 64 + m * 16 + fr) * 4 + wc] = sq;
            }
        asm volatile("s_waitcnt lgkmcnt(0)" ::: "memory"); __builtin_amdgcn_s_barrier(); asm volatile("" ::: "memory");
        const int tid = (wr * 4 + wc) * 64 + fq * 16 + fr;
        if (tid < 256) { const pf4 p = *(const LAS pf4*)(part + tid * 4); ss[(size_t)(u.pm * 256 + tid) * 8 + u.pn] = (p[0] + p[1]) + (p[2] + p[3]); }
    }
};
struct EpiProjA {
    static constexpr bool PERM = true, AFTER_DRAIN = false;
    unsigned char* ws; bf16* rxp; bf16* rgp; const float* ss;
    __device__ __forceinline__ void operator()(const pf4 (&acc)[2][2][4][2], const pg8::Unit& u, int wr, int wc, int fr, int fq) const {
        const int pn = u.pn, row0 = u.pm * 256 + wr * 64 + fr, cw = wc * 32 + 8 * fq;
        float rs[2][4]; load_rstd(ss, row0, rs);
        if (pn < 26 || pn >= 28) {
            bf16* base; int ldc, ct; bool gel = false, sig = false;
            if (pn < 8) { base = rxp; ldc = DM; ct = pn; }
            else if (pn < 16) { base = rgp; ldc = DM; ct = pn - 8; gel = true; }
            else if (pn < 24) { base = (bf16*)(ws + WS_Q); ldc = DM; ct = pn - 16; }
            else if (pn < 26) { base = (bf16*)(ws + WS_K); ldc = KVW; ct = pn - 24; }
            else if (pn < 32) { base = (bf16*)(ws + WS_IQ); ldc = IQW; ct = pn - 28; }
            else if (pn < 40) { base = (bf16*)(ws + WS_SGR); ldc = DM; ct = pn - 32; sig = true; }
            else { base = (bf16*)(ws + WS_SGA); ldc = DM; ct = pn - 40; sig = true; }
#pragma unroll
            for (int ai = 0; ai < 2; ++ai)
#pragma unroll
                for (int m = 0; m < 4; ++m) {
                    bf16* rowp = base + (size_t)(row0 + ai * 128 + m * 16) * ldc + ct * 256 + cw;
                    const float r = rs[ai][m];
#pragma unroll
                    for (int bj = 0; bj < 2; ++bj) {
                        pf4 v0 = acc[ai][bj][m][0] * r, v1 = acc[ai][bj][m][1] * r;
                        if (gel) {
#pragma unroll
                            for (int j = 0; j < 4; ++j) { v0[j] = gelu_tanh(v0[j]); v1[j] = gelu_tanh(v1[j]); }
                        }
                        if (sig) {
#pragma unroll
                            for (int j = 0; j < 4; ++j) { v0[j] = sigmoidf_(v0[j]); v1[j] = sigmoidf_(v1[j]); }
                        }
                        pu4 w; w.x = cvtpk(v0[0], v0[1]); w.y = cvtpk(v0[2], v0[3]); w.z = cvtpk(v1[0], v1[1]); w.w = cvtpk(v1[2], v1[3]);
                        *(pu4*)(rowp + bj * 128) = w;
                    }
                }
        } else {
            bf16* vt = (bf16*)(ws + WS_VT);
#pragma unroll
            for (int ai = 0; ai < 2; ++ai)
#pragma unroll
                for (int m = 0; m < 4; ++m) {
                    const int row = row0 + ai * 128 + m * 16, b = row >> 11, s = row & 2047;
                    const float r = rs[ai][m];
#pragma unroll
                    for (int bj = 0; bj < 2; ++bj) {
                        const int dabs = (pn - 26) * 256 + bj * 128 + cw;
                        bf16* p = vt + ((size_t)(b * 4 + (dabs >> 7)) * 128 + (dabs & 127)) * SEQ + s;
                        const pf4 v0 = acc[ai][bj][m][0] * r, v1 = acc[ai][bj][m][1] * r;
#pragma unroll
                        for (int j = 0; j < 4; ++j) { p[(size_t)j * SEQ] = (bf16)f2bf(v0[j]); p[(size_t)(4 + j) * SEQ] = (bf16)f2bf(v1[j]); }
                    }
                }
        }
    }
};
template <bool ADD> struct EpiGateMul {
    static constexpr bool PERM = true, AFTER_DRAIN = false;
    const bf16* G; bf16* O;
    __device__ __forceinline__ void operator()(const pf4 (&acc)[2][2][4][2], const pg8::Unit& u, int wr, int wc, int fr, int fq) const {
        const int row0 = u.pm * 256 + wr * 64 + fr, col = u.pn * 256 + wc * 32 + 8 * fq;
#pragma unroll
        for (int ai = 0; ai < 2; ++ai)
#pragma unroll
            for (int m = 0; m < 4; ++m) {
                const size_t ro = (size_t)(row0 + ai * 128 + m * 16) * DM + col;
#pragma unroll
                for (int bj = 0; bj < 2; ++bj) {
                    const pu4 g = *(const pu4*)(G + ro + bj * 128);
                    pu4 o = (pu4){0u, 0u, 0u, 0u}; if (ADD) o = *(const pu4*)(O + ro + bj * 128);
                    const pf4 v0 = acc[ai][bj][m][0], v1 = acc[ai][bj][m][1];
                    float r[8];
#pragma unroll
                    for (int j = 0; j < 4; ++j) {
                        const float a0 = j < 2 ? v0[2 * j] : v1[2 * j - 4], a1 = j < 2 ? v0[2 * j + 1] : v1[2 * j - 3];
                        r[2 * j] = bfl(g[j]) * a0 + (ADD ? bfl(o[j]) : 0.f);
                        r[2 * j + 1] = bfh(g[j]) * a1 + (ADD ? bfh(o[j]) : 0.f);
                    }
                    pu4 w; w.x = cvtpk(r[0], r[1]); w.y = cvtpk(r[2], r[3]); w.z = cvtpk(r[4], r[5]); w.w = cvtpk(r[6], r[7]);
                    *(pu4*)(O + ro + bj * 128) = w;
                }
            }
    }
};


__device__ __forceinline__ void ikiw_unit(unsigned char* ws, LAS unsigned char* lds, int blk, int tid) {
    const int lane = tid & 63, wave = __builtin_amdgcn_readfirstlane(tid >> 6), fr = lane & 15, fq = lane >> 4, rt = wave & 3, kh = wave >> 2;
    const bf16* ap = (const bf16*)(ws + WS_XB) + (size_t)(64 * blk + 16 * rt + fr) * DM + kh * 1024 + 8 * fq;
    const bf16* bp = (const bf16*)(ws + WS_WIKT) + (size_t)fr * DM + kh * 1024 + 8 * fq;
    pf4 acc[5];
#pragma unroll
    for (int ct = 0; ct < 5; ++ct) acc[ct] = (pf4){0.f, 0.f, 0.f, 0.f};
#pragma unroll 4
    for (int ks = 0; ks < 32; ++ks) {
        const bf16x8 a = *(const bf16x8*)(ap + 32 * ks);
#pragma unroll
        for (int ct = 0; ct < 5; ++ct) { const bf16x8 bfr = *(const bf16x8*)(bp + (size_t)ct * 16 * DM + 32 * ks); acc[ct] = __builtin_amdgcn_mfma_f32_16x16x32_bf16(a, bfr, acc[ct], 0, 0, 0); }
    }
    LAS pf4* red = (LAS pf4*)lds;
    if (kh == 1) {
#pragma unroll
        for (int ct = 0; ct < 5; ++ct) red[(rt * 5 + ct) * 64 + lane] = acc[ct];
    }
    __syncthreads();
    if (kh == 0) {
        const float* ss = (const float*)(ws + WS_SS1); bf16* IK = (bf16*)(ws + WS_IK); float* IW = (float*)(ws + WS_IW);
#pragma unroll
        for (int i = 0; i < 4; ++i) {
            const int row = 64 * blk + 16 * rt + 4 * fq + i;
            const pf4* p = (const pf4*)(ss + (size_t)row * 8); const pf4 a = p[0], b = p[1];
            const float rstd = __builtin_amdgcn_rsqf((((a[0] + a[1]) + (a[2] + a[3])) + ((b[0] + b[1]) + (b[2] + b[3]))) * (1.0f / DM) + RMS_EPS);
#pragma unroll
            for (int ct = 0; ct < 5; ++ct) {
                const float v = (acc[ct][i] + red[(rt * 5 + ct) * 64 + lane][i]) * rstd;
                if (ct < 4) IK[(size_t)row * 64 + 16 * ct + fr] = (bf16)f2bf(v); else IW[(size_t)row * 16 + fr] = v * 0.03125f;
            }
        }
    }
    __syncthreads();
}

struct TrJob { const float* W; bf16* dst; const float* gs; int ldw, Kdst, row0, k0, n0; };
struct TrRegs { f32x4 v[8]; f32x4 g0, g1; };
__device__ __forceinline__ void tr_load(const TrJob& j, TrRegs& r, int lane) {
    const float* p = j.W + (size_t)(j.k0 + (lane >> 3)) * j.ldw + j.n0 + (lane & 7) * 4;
#pragma unroll
    for (int i = 0; i < 8; ++i) r.v[i] = __builtin_nontemporal_load((const f32x4*)(p + (size_t)(8 * i) * j.ldw));
    const f32x4* g = (const f32x4*)((j.gs ? j.gs + j.k0 : j.W) + 8 * (lane & 7)); r.g0 = g[0]; r.g1 = g[1];
}
__device__ __forceinline__ void tr_finish(const TrJob& j, const TrRegs& r, LAS float* scr, int lane) {
    const int cq = (lane & 7) * 4, kr = lane >> 3;
#pragma unroll
    for (int i = 0; i < 8; ++i) { LAS float* s = scr + (8 * i + kr) * 33 + cq; s[0] = r.v[i].x; s[1] = r.v[i].y; s[2] = r.v[i].z; s[3] = r.v[i].w; }
    LDS_WAIT(); asm volatile("" ::: "memory");
    const f32x4 one = {1.f, 1.f, 1.f, 1.f}; const f32x4 g0 = j.gs ? r.g0 : one, g1 = j.gs ? r.g1 : one;
    const int c = lane & 7;
#pragma unroll
    for (int jj = 0; jj < 4; ++jj) { const int n = (lane >> 3) + 8 * jj; const LAS float* s = scr + (8 * c) * 33 + n;
        v4u o; o.x = cvtpk(s[0 * 33] * g0.x, s[1 * 33] * g0.y); o.y = cvtpk(s[2 * 33] * g0.z, s[3 * 33] * g0.w);
        o.z = cvtpk(s[4 * 33] * g1.x, s[5 * 33] * g1.y); o.w = cvtpk(s[6 * 33] * g1.z, s[7 * 33] * g1.w);
        *(GAS v4u*)(j.dst + (size_t)(j.row0 + n) * j.Kdst + j.k0 + 8 * c) = o; }
    LDS_WAIT(); asm volatile("" ::: "memory");
}
constexpr int IG_FFN = (DM / 64) * (DFF / 32);
constexpr int N_FFN_ITEMS = 3 * IG_FFN;
constexpr int I_WA = 32 * 256, I_WK = 32 * 3, I_WB = 32 * 128, I_SQ = 32 * 64, I_RG = 128;
constexpr int N_MIX_ITEMS = I_WA + I_WK + I_WB + 3 * I_SQ + 2 * I_RG;
constexpr int N_CONV_ITEMS = 2 * N_FFN_ITEMS + N_MIX_ITEMS;
__device__ __forceinline__ void ffn_job(const float* wg, const float* wu, const float* wd, bf16* dgu, bf16* dd, const float* gs, int r, TrJob& j) {
    if (r < 2 * IG_FFN) { const bool up = r >= IG_FFN; const int rr = up ? r - IG_FFN : r; const int kb = rr / (DFF / 32), nb = rr % (DFF / 32), n0 = nb * 32;
        j = TrJob{up ? wu : wg, dgu, gs, DFF, DM, 256 * (n0 >> 7) + (up ? 128 : 0) + (n0 & 127), kb * 64, n0}; }
    else { const int rr = r - 2 * IG_FFN; const int kb = rr / (DM / 32), nb = rr % (DM / 32);
        j = TrJob{wd, dd, nullptr, DM, DFF, nb * 32, kb * 64, nb * 32}; }
}
__device__ __forceinline__ void conv_job(const float* const* in, unsigned char* ws, int r, TrJob& j) {
    if (r < N_FFN_ITEMS) { ffn_job(in[2], in[3], in[4], (bf16*)(ws + WS_WGU), (bf16*)(ws + WS_WD), nullptr, r, j); return; } r -= N_FFN_ITEMS;
    if (r < N_FFN_ITEMS) { ffn_job(in[19], in[20], in[21], (bf16*)(ws + WS_WGU2), (bf16*)(ws + WS_WD2), in[18], r, j); return; } r -= N_FFN_ITEMS;
    const float* gm = in[5];
    if (r < I_WA) { const int kb = r / 256, nb = r % 256; j = TrJob{in[6], (bf16*)(ws + WS_WA), gm, NIN, DM, nb * 32, kb * 64, nb * 32}; return; } r -= I_WA;
    if (r < I_WK) { const int kb = r / 3, nb = r % 3; j = TrJob{in[6] + NA, (bf16*)(ws + WS_WIKT), gm, NIN, DM, nb * 32, kb * 64, nb * 32}; return; } r -= I_WK;
    if (r < I_WB) { const int kb = r / 128, nb = r % 128; j = TrJob{in[6] + NA + NIKW, (bf16*)(ws + WS_WB), gm, NIN, DM, nb * 32, kb * 64, nb * 32}; return; } r -= I_WB;
    if (r < 3 * I_SQ) { const int w = r / I_SQ, rr = r % I_SQ, kb = rr / 64, nb = rr % 64;
        const float* src = w == 0 ? in[15] : (w == 1 ? in[16] : in[17]); const size_t off = w == 0 ? WS_WPR : (w == 1 ? WS_WPA : WS_WOUT);
        j = TrJob{src, (bf16*)(ws + off), nullptr, DM, DM, nb * 32, kb * 64, nb * 32}; return; } r -= 3 * I_SQ;
    { const int w = r / I_RG, rr = r % I_RG, mat = rr / 8, q = rr % 8, kb = q / 4, nb = q % 4;
      j = TrJob{(w ? in[11] : in[9]) + mat * 16384, (bf16*)(ws + (w ? WS_RGX : WS_RGA)) + mat * 16384, nullptr, 128, 128, nb * 32, kb * 64, nb * 32}; }
}
constexpr int CV_A0 = 0, CV_A1 = 2 * IG_FFN, CV_B0 = N_FFN_ITEMS, CV_B1 = N_FFN_ITEMS + 2 * IG_FFN, CV_C0 = 2 * N_FFN_ITEMS, CV_C1 = CV_C0 + I_WA + I_WK + I_WB, CV_C2 = CV_C1 + 3 * I_SQ;
static_assert(CV_C2 + 2 * I_RG == N_CONV_ITEMS, "conv ranges");
struct ConvList { int s0, n0, s1, n1, s2, n2;
    __device__ __forceinline__ int total() const { return n0 + n1 + n2; }
    __device__ __forceinline__ int at(int v) const { return v < n0 ? s0 + v : (v < n0 + n1 ? s1 + (v - n0) : s2 + (v - n0 - n1)); } };
__device__ __forceinline__ void conv_list(const float* const* in, unsigned char* ws, const ConvList& L, int first, int last, int gw, int NGW, LAS float* scr, int lane) {
    int it = first + gw;
    TrJob j[4]; TrRegs r[4];
    if (it + 7 * NGW < last) {
#pragma unroll
        for (int d = 0; d < 4; ++d) { conv_job(in, ws, L.at(it + d * NGW), j[d]); tr_load(j[d], r[d], lane); }
        do {
#pragma unroll
            for (int d = 0; d < 4; ++d) { tr_finish(j[d], r[d], scr, lane); conv_job(in, ws, L.at(it + 4 * NGW), j[d]); tr_load(j[d], r[d], lane); it += NGW; }
        } while (it + 7 * NGW < last);
    } else {
#pragma unroll
        for (int d = 0; d < 4; ++d) if (it + d * NGW < last) { conv_job(in, ws, L.at(it + d * NGW), j[d]); tr_load(j[d], r[d], lane); }
    }
    while (it < last) {
#pragma unroll
        for (int d = 0; d < 4; ++d) {
            if (it < last) {
                tr_finish(j[d], r[d], scr, lane);
                const int itn = it + 4 * NGW;
                if (itn < last) { conv_job(in, ws, L.at(itn), j[d]); tr_load(j[d], r[d], lane); }
            }
            it += NGW;
        }
    }
}
template <bool TO_F32>
__device__ __forceinline__ void rms_rows(const float* x, const float* g, void* outp, int gw, int NGW, int lane) {
    f32x4 gv[8];
#pragma unroll
    for (int j = 0; j < 8; ++j) gv[j] = ((const f32x4*)g)[lane + 64 * j];
    for (int m = gw; m < MTOK; m += NGW) {
        const f32x4* xr = (const f32x4*)(x + (size_t)m * DM) + lane;
        f32x4 v[8]; float s = 0.f;
#pragma unroll
        for (int j = 0; j < 8; ++j) { v[j] = __builtin_nontemporal_load(xr + 64 * j); s += (v[j].x * v[j].x + v[j].y * v[j].y) + (v[j].z * v[j].z + v[j].w * v[j].w); }
        const float rstd = 1.0f / sqrtf(wave_sum(s) * (1.0f / DM) + RMS_EPS);
        if (TO_F32) { f32x4* o = (f32x4*)((float*)outp + (size_t)m * DM) + lane;
#pragma unroll
            for (int j = 0; j < 8; ++j) o[64 * j] = v[j] * rstd * gv[j]; }
        else { unsigned long long* o8 = (unsigned long long*)((bf16*)outp + (size_t)m * DM) + lane;
#pragma unroll
            for (int j = 0; j < 8; ++j) { const f32x4 y = v[j] * rstd * gv[j]; o8[64 * j] = (unsigned long long)cvtpk(y.x, y.y) | ((unsigned long long)cvtpk(y.z, y.w) << 32); } }
    }
}

__device__ __forceinline__ void rms_out_rows(const bf16* xb, const float* ss, const float* g, float* out, int gw, int NGW, int lane) {
    f32x4 gv[8];
#pragma unroll
    for (int j = 0; j < 8; ++j) gv[j] = ((const f32x4*)g)[lane + 64 * j];
    for (int m = gw; m < MTOK; m += NGW) {
        const f32x4* p = (const f32x4*)(ss + (size_t)m * 8); const f32x4 a = p[0], b = p[1];
        const float rstd = __builtin_amdgcn_rsqf((((a.x + a.y) + (a.z + a.w)) + ((b.x + b.y) + (b.z + b.w))) * (1.0f / DM) + RMS_EPS);
        const v2u* xr = (const v2u*)(xb + (size_t)m * DM) + lane;
        f32x4* o = (f32x4*)(out + (size_t)m * DM) + lane;
#pragma unroll
        for (int j = 0; j < 8; ++j) { const v2u w = __builtin_nontemporal_load(xr + 64 * j); const f32x4 x = {bfl(w.x), bfh(w.x), bfl(w.y), bfh(w.y)};
            __builtin_nontemporal_store(x * rstd * gv[j], o + 64 * j);
        }
    }
}
#ifdef PROBE_IDX
#define IDP(k) do { if (blockIdx.x == 0 && tid < 64) { asm volatile("s_waitcnt lgkmcnt(0)" ::: "memory"); __builtin_amdgcn_sched_barrier(0); const unsigned now_ = (unsigned)__builtin_amdgcn_s_memrealtime(); \
    volatile LAS unsigned* M_ = (volatile LAS unsigned*)(lds + MISC_OFF); if (tid == 0) { if ((k) != 0) M_[40 + (k)] += now_ - M_[39]; M_[39] = now_; } __builtin_amdgcn_sched_barrier(0); } } while (0)
#else
#define IDP(k) do { } while (0)
#endif
#ifdef PROBE_RNN
#define RTP(k) do { if (blockIdx.x == 0 && tid < 64) { asm volatile("s_waitcnt lgkmcnt(0)" ::: "memory"); __builtin_amdgcn_sched_barrier(0); const unsigned now_ = (unsigned)__builtin_amdgcn_s_memrealtime(); \
    volatile LAS unsigned* M_ = (volatile LAS unsigned*)(lds + MISC_OFF); if (tid == 0) { if ((k) != 0) M_[40 + (k)] += now_ - M_[39]; M_[39] = now_; } __builtin_amdgcn_sched_barrier(0); } } while (0)
#else
#define RTP(k) do { } while (0)
#endif
#ifdef PROBE_ATT
#define ATP(k) do { if (blockIdx.x == 0 && tid < 64) { asm volatile("s_waitcnt vmcnt(0) lgkmcnt(0)" ::: "memory"); __builtin_amdgcn_sched_barrier(0); const unsigned now_ = (unsigned)__builtin_amdgcn_s_memrealtime(); \
    volatile LAS unsigned* M_ = (volatile LAS unsigned*)(lds + MISC_OFF); if (tid == 0) { if ((k) != 0) M_[40 + (k)] += now_ - M_[39]; M_[39] = now_; } __builtin_amdgcn_sched_barrier(0); } } while (0)
#else
#define ATP(k) do { } while (0)
#endif

constexpr int RN_XCB = 0, RN_XCB_PITCH = 272, RN_XCB_SZ = 64 * 272;
constexpr int RN_XCF = 2 * RN_XCB_SZ, RN_XCF_SZ = 64 * 64 * 4;
constexpr int RN_PRE = RN_XCF + 2 * RN_XCF_SZ, RN_PP = 68;
constexpr int RN_PART = RN_PRE + 2 * 64 * 68 * 4;
constexpr int RN_CARRY = RN_PART + 4096;
static_assert(RN_CARRY + 512 <= 131072, "RG-LRU LDS map");
__device__ __forceinline__ void rnn_unit(const float* const* in, unsigned char* ws, const bf16* RX, bf16* RG, LAS unsigned char* lds, int unit, int tid) {
    const int lane = tid & 63, wave = __builtin_amdgcn_readfirstlane(tid >> 6);
    const int b = unit >> 5, n = (unit >> 1) & 15, hf = unit & 1;
    const int cg = tid & 15, tp = tid >> 4, chc = 128 * n + 8 * cg;
    float cw[4][8], cb[8];
#pragma unroll
    for (int k = 0; k < 4; ++k) { const f32x4 a = *(const f32x4*)(in[7] + k * DM + chc), c = *(const f32x4*)(in[7] + k * DM + chc + 4);
        cw[k][0] = a.x; cw[k][1] = a.y; cw[k][2] = a.z; cw[k][3] = a.w; cw[k][4] = c.x; cw[k][5] = c.y; cw[k][6] = c.z; cw[k][7] = c.w; }
    { const f32x4 a = *(const f32x4*)(in[8] + chc), c = *(const f32x4*)(in[8] + chc + 4); cb[0] = a.x; cb[1] = a.y; cb[2] = a.z; cb[3] = a.w; cb[4] = c.x; cb[5] = c.y; cb[6] = c.z; cb[7] = c.w; }
    const int chs = 128 * n + 64 * hf + lane;
    const float ba = in[10][chs], bx = in[12][chs];
    const float lam = in[13][chs];
    const float c8 = -8.0f * log1pf(expf(-lam));
    const int g = wave >> 2, ct = wave & 3, fr = lane & 15, fq = lane >> 4;
    bf16x8 Bf[4];
    { const bf16* wt = (const bf16*)(ws + (g ? WS_RGX : WS_RGA)) + (size_t)n * 16384 + (size_t)(64 * hf + 16 * ct + fr) * 128 + 8 * fq;
#pragma unroll
      for (int ks = 0; ks < 4; ++ks) Bf[ks] = *(const bf16x8*)(wt + 32 * ks); }
    LAS float* pre = (LAS float*)(lds + RN_PRE); LAS float* part = (LAS float*)(lds + RN_PART); LAS float* carry = (LAS float*)(lds + RN_CARRY);
    if (tid < 64) carry[tid] = 0.f;
    const float c8l = c8 * LOG2E;
    v4u vn[5]; unsigned short gn[8];
    const unsigned char* rxb = (const unsigned char*)RX; const unsigned char* rgb = (const unsigned char*)RG;
    const unsigned rxo = (unsigned)((b * SEQ * DM + chc) * 2), rgo = (unsigned)(((b * SEQ + 8 * wave) * DM + chs) * 2);
    constexpr int NCK = SEQ / 64;
#define RN_LOADX(ckk) do { const int ck_ = (ckk) < NCK ? (ckk) : NCK - 1; const int tb_ = ck_ * 64 + 2 * tp - 3; \
        _Pragma("unroll") for (int i = 0; i < 5; ++i) { const int tt_ = tb_ + i; const v4u x_ = *(const v4u*)(rxb + rxo + (unsigned)(tt_ < 0 ? 0 : tt_) * (DM * 2));     \
            vn[i] = tt_ >= 0 ? x_ : (v4u){0u, 0u, 0u, 0u}; } } while (0)
#define RN_LOADG(ckk) do { const int ck_ = (ckk) < NCK ? (ckk) : NCK - 1; const unsigned g_ = rgo + (unsigned)ck_ * (64 * DM * 2); \
        _Pragma("unroll") for (int i = 0; i < 8; ++i) gn[i] = *(const unsigned short*)(rgb + g_ + (unsigned)i * (DM * 2)); } while (0)
#define RN_CONV(v_, par_) do { _Pragma("unroll") for (int u = 0; u < 2; ++u) { float xc[8]; \
            _Pragma("unroll") for (int j = 0; j < 8; ++j) xc[j] = cb[j]; \
            _Pragma("unroll") for (int k = 0; k < 4; ++k) { const v4u r = v_[u + k]; \
                _Pragma("unroll") for (int j = 0; j < 4; ++j) { xc[2 * j] += cw[k][2 * j] * bfl(r[j]); xc[2 * j + 1] += cw[k][2 * j + 1] * bfh(r[j]); } } \
            const int t = 2 * tp + u; \
            const v4u w = {cvtpk(xc[0], xc[1]), cvtpk(xc[2], xc[3]), cvtpk(xc[4], xc[5]), cvtpk(xc[6], xc[7])}; \
            *(LAS v4u*)(lds + RN_XCB + (par_) * RN_XCB_SZ + t * RN_XCB_PITCH + cg * 16) = w; \
            if ((cg >> 3) == hf) { LAS f32x4* d = (LAS f32x4*)(lds + RN_XCF + (par_) * RN_XCF_SZ + (t * 64 + 8 * (cg & 7)) * 4); d[0] = (f32x4){xc[0], xc[1], xc[2], xc[3]}; d[1] = (f32x4){xc[4], xc[5], xc[6], xc[7]}; } } } while (0)
    RN_LOADX(0);
    { v4u v0[5];
#pragma unroll
      for (int i = 0; i < 5; ++i) v0[i] = vn[i];
      RN_LOADX(1); RN_LOADG(0);
      RN_CONV(v0, 0); }
    __syncthreads();
    for (int ck = 0; ck < NCK; ++ck) {
        const int t0 = ck * 64, par = ck & 1;
        RTP(0);
        v4u v[5]; unsigned short gl[8];
#pragma unroll
        for (int i = 0; i < 5; ++i) v[i] = vn[i];
#pragma unroll
        for (int i = 0; i < 8; ++i) gl[i] = gn[i];
        RN_LOADX(ck + 2); RN_LOADG(ck + 1);
        { pg8::f32x4 acc[4];
          const LAS unsigned char* xa = lds + RN_XCB + par * RN_XCB_SZ + fr * RN_XCB_PITCH + 16 * fq;
#pragma unroll
          for (int rt = 0; rt < 4; ++rt) acc[rt] = (pg8::f32x4){0.f, 0.f, 0.f, 0.f};
#pragma unroll
          for (int ks = 0; ks < 4; ++ks)
#pragma unroll
              for (int rt = 0; rt < 4; ++rt)
                  acc[rt] = __builtin_amdgcn_mfma_f32_16x16x32_bf16(*(const LAS bf16x8*)(xa + 16 * rt * RN_XCB_PITCH + 64 * ks), Bf[ks], acc[rt], 0, 0, 0);
          RN_CONV(v, par ^ 1);
#pragma unroll
          for (int rt = 0; rt < 4; ++rt)
#pragma unroll
              for (int i = 0; i < 4; ++i) pre[(g * 64 + 16 * rt + 4 * fq + i) * RN_PP + 16 * ct + fr] = acc[rt][i]; }
        RTP(3);
        __syncthreads();
        RTP(4);
        const LAS float* xcfp = (const LAS float*)(lds + RN_XCF + par * RN_XCF_SZ);
        float av[8], uv[8]; float Aloc = 1.f, Hloc = 0.f;
#pragma unroll
        for (int i = 0; i < 8; ++i) {
            const int t = 8 * wave + i;
            const float r = sigmoidf_(pre[t * RN_PP + lane] + ba), ig = sigmoidf_(pre[(64 + t) * RN_PP + lane] + bx);
            const float a = fast_exp2(c8l * r), mult = __builtin_amdgcn_sqrtf(fmaxf(1.0f - a * a, 0.f));
            const float uu = mult * (ig * xcfp[t * 64 + lane]);
            av[i] = a; uv[i] = uu; Hloc = a * Hloc + uu; Aloc *= a;
        }
        part[(wave * 64 + lane) * 2] = Aloc; part[(wave * 64 + lane) * 2 + 1] = Hloc;
        RTP(5);
        __syncthreads();
        RTP(6);
        float h = carry[(ck & 1) * 64 + lane];
        { f32x2_t ph[7];
#pragma unroll
          for (int s = 0; s < 7; ++s) ph[s] = *(const LAS f32x2_t*)(part + (s * 64 + lane) * 2);
#pragma unroll
          for (int s = 0; s < 7; ++s) if (s < wave) h = ph[s].x * h + ph[s].y; }
#pragma unroll
        for (int i = 0; i < 8; ++i) {
            h = av[i] * h + uv[i];
            *(unsigned short*)((unsigned char*)RG + rgo + (unsigned)ck * (64 * DM * 2) + (unsigned)i * (DM * 2)) = (unsigned short)f2bf(h * bf2f(gl[i]));
        }
        if (wave == 7) carry[((ck + 1) & 1) * 64 + lane] = h;
        RTP(7);
    }
#undef RN_LOADX
#undef RN_LOADG
#undef RN_CONV
    __syncthreads();
}

__device__ __forceinline__ void idx_scores(unsigned char* ws, LAS unsigned char* lds, int b, int qb, int tid) {
    const int lane = tid & 63, wave = __builtin_amdgcn_readfirstlane(tid >> 6), r32 = lane & 31, h = lane >> 5;
    const bf16* IQ = (const bf16*)(ws + WS_IQ); const bf16* IK = (const bf16*)(ws + WS_IK); const float* IW = (const float*)(ws + WS_IW);
    const int qa = 16 * qb + 2 * wave;
    const int qpos = qa + h;
    IDP(0);
    bf16x8 af[4];
    { const int qm = qa + ((r32 >> 2) & 1), hd = (r32 & 3) + 4 * (r32 >> 3);
      const bf16* p = IQ + (size_t)(b * SEQ + qm) * IQW + hd * 64 + 8 * h;
#pragma unroll
      for (int kk = 0; kk < 4; ++kk) af[kk] = *(const bf16x8*)(p + 16 * kk); }
    float wv[16];
    { const f32x4* p = (const f32x4*)(IW + (size_t)(b * SEQ + qpos) * 16);
#pragma unroll
      for (int j = 0; j < 4; ++j) { const f32x4 t = p[j]; wv[4 * j] = t.x; wv[4 * j + 1] = t.y; wv[4 * j + 2] = t.z; wv[4 * j + 3] = t.w; } }
    LAS float* sl = (LAS float*)(lds + wave * 16384 + h * 8192) + r32;
    const int kbmax = (16 * qb + 15) >> 5;
    const float NEG = -__builtin_inff();
    constexpr int IKP = 144, IKB = 64 * IKP;
    LAS unsigned char* stg = lds + XTRA_OFF;
    const int skey = tid >> 3, spart = tid & 7;
    const bf16* ikg = IK + (size_t)(b * SEQ + skey) * 64 + spart * 8;
    const int ntile = kbmax / 2 + 1;
    const int lt = ntile - 1;
#define IDX_LD(tt) (*(const v4u*)(ikg + (size_t)((tt) < lt ? (tt) : lt) * 64 * 64))
    v4u stA = IDX_LD(0), stB = IDX_LD(1);
    *(LAS v4u*)(stg + skey * IKP + spart * 16) = stA;
    *(LAS v4u*)(stg + IKB + skey * IKP + spart * 16) = stB;
    __syncthreads();
    stA = IDX_LD(2);
    f32x16 pa0, pa1, pb0, pb1;
    { const LAS unsigned char* bb = stg + r32 * IKP + 16 * h;
#pragma unroll
      for (int r = 0; r < 16; ++r) { pa0[r] = 0.f; pa1[r] = 0.f; }
#pragma unroll
      for (int kk = 0; kk < 4; ++kk) { pa0 = __builtin_amdgcn_mfma_f32_32x32x16_bf16(af[kk], *(const LAS bf16x8*)(bb + 32 * kk), pa0, 0, 0, 0);
                                       pa1 = __builtin_amdgcn_mfma_f32_32x32x16_bf16(af[kk], *(const LAS bf16x8*)(bb + 32 * IKP + 32 * kk), pa1, 0, 0, 0); } }
    __syncthreads();
#define IDX_STEP(bufo, n0_, n1_, c0_, c1_, t_, wr_) do { const LAS unsigned char* bb = stg + (bufo) + r32 * IKP + 16 * h; \
        bf16x8 bq[8]; \
        _Pragma("unroll") for (int kk = 0; kk < 4; ++kk) { bq[2 * kk] = *(const LAS bf16x8*)(bb + 32 * kk); bq[2 * kk + 1] = *(const LAS bf16x8*)(bb + 32 * IKP + 32 * kk); } \
        _Pragma("unroll") for (int r = 0; r < 16; ++r) { n0_[r] = 0.f; n1_[r] = 0.f; } \
        float s0_ = 0.f, s1_ = 0.f; \
        _Pragma("unroll") for (int kk = 0; kk < 4; ++kk) { \
            n0_ = __builtin_amdgcn_mfma_f32_32x32x16_bf16(af[kk], bq[2 * kk], n0_, 0, 0, 0); n1_ = __builtin_amdgcn_mfma_f32_32x32x16_bf16(af[kk], bq[2 * kk + 1], n1_, 0, 0, 0); \
            _Pragma("unroll") for (int r = 4 * kk; r < 4 * kk + 4; ++r) { s0_ += wv[r] * __builtin_amdgcn_fmed3f(c0_[r], 0.f, __builtin_inff()); s1_ += wv[r] * __builtin_amdgcn_fmed3f(c1_[r], 0.f, __builtin_inff()); } \
            __builtin_amdgcn_sched_group_barrier(0x008, 2, 0); __builtin_amdgcn_sched_group_barrier(0x002, 16, 0); } \
        if (wr_) { const int k0_ = 64 * (t_) + r32; sl[(2 * (t_)) * 32] = (k0_ <= qpos) ? s0_ : NEG; sl[(2 * (t_) + 1) * 32] = (k0_ + 32 <= qpos) ? s1_ : NEG; } } while (0)
    IDP(1);
    for (int t = 0; t < ntile; t += 2) {
        stB = IDX_LD(t + 3);
        IDP(0);
        IDX_STEP(IKB, pb0, pb1, pa0, pa1, t, true);
        IDP(7);
        *(LAS v4u*)(stg + skey * IKP + spart * 16) = stA;
        __syncthreads();
        stA = IDX_LD(t + 4);
        IDX_STEP(0, pa0, pa1, pb0, pb1, t + 1, (t + 1 < ntile));
        *(LAS v4u*)(stg + IKB + skey * IKP + spart * 16) = stB;
        __syncthreads();
    }
#undef IDX_STEP
#undef IDX_LD
    IDP(2);
    for (int kb = 2 * ntile; kb < 64; ++kb) sl[kb * 32] = NEG;
    LDS_WAIT(); asm volatile("" ::: "memory");
    IDP(3);
}
__device__ __forceinline__ int dpp_row_sum(int v) {
    v += __builtin_amdgcn_update_dpp(0, v, 0xB1, 0xF, 0xF, false);
    v += __builtin_amdgcn_update_dpp(0, v, 0x4E, 0xF, 0xF, false);
    v += __builtin_amdgcn_update_dpp(0, v, 0x141, 0xF, 0xF, false);
    v += __builtin_amdgcn_update_dpp(0, v, 0x140, 0xF, 0xF, false);
    return v;
}
__device__ __forceinline__ void idx_select(unsigned char* ws, LAS unsigned char* lds, int b, int qb, int tid) {
    const int lane = tid & 63, wave = __builtin_amdgcn_readfirstlane(tid >> 6), r32 = lane & 31, h = lane >> 5;
    unsigned* MASK = (unsigned*)(ws + WS_MASK);
    const int qa = 16 * qb + 2 * wave;
    LAS float* sl = (LAS float*)(lds + wave * 16384 + h * 8192) + r32;
    IDP(0);
    float sv[64];
#pragma unroll
    for (int j = 0; j < 64; ++j) sv[j] = sl[j * 32];
    const float NINF = -__builtin_inff();
    float T = -3.0e38f;
    bool doneA = (qa + 1 <= 256), doneB = (qa + 2 <= 256);
    if (!(doneA && doneB)) {
        float mn = 3.0e38f, mx = -3.0e38f;
#pragma unroll
        for (int j = 0; j < 64; ++j) { mx = fmaxf(mx, sv[j]); mn = fminf(mn, sv[j] == NINF ? 3.0e38f : sv[j]); }
#pragma unroll
        for (int o = 1; o < 32; o <<= 1) { mx = fmaxf(mx, __shfl_xor(mx, o)); mn = fminf(mn, __shfl_xor(mn, o)); }
        float lo = mn, hi = mx;
        bool done = h ? doneB : doneA;
        if (!done) T = lo;
        for (int it = 0; it < 64; ++it) {
            if (doneA && doneB) break;
            const float mid = lo + 0.5f * (hi - lo);
            unsigned bv0 = 0u, bv1 = 0u;
#pragma unroll
            for (int j = 0; j < 32; ++j) { bv0 = __builtin_amdgcn_alignbit(bv0, __builtin_bit_cast(unsigned, sv[j] - mid), 31); bv1 = __builtin_amdgcn_alignbit(bv1, __builtin_bit_cast(unsigned, sv[32 + j] - mid), 31); }
            int cnt = 64 - (__builtin_popcount(bv0) + __builtin_popcount(bv1));
            cnt = dpp_row_sum(cnt);
            const int cA = __builtin_amdgcn_readlane(cnt, 0) + __builtin_amdgcn_readlane(cnt, 16), cB = __builtin_amdgcn_readlane(cnt, 32) + __builtin_amdgcn_readlane(cnt, 48);
            const int c = h ? cB : cA;
            if (!done) {
                if (!(mid > lo && mid < hi)) { T = lo; done = true; }
                else if (c == 256) { T = mid; done = true; }
                else if (c > 256) { lo = mid; T = mid; }
                else hi = mid;
            }
            doneA = __builtin_amdgcn_readlane((int)done, 0) != 0; doneB = __builtin_amdgcn_readlane((int)done, 32) != 0;
        }
    }
    IDP(5);
    unsigned long long myw = 0ull;
#pragma unroll
    for (int j = 0; j < 64; ++j) { const unsigned long long bal = __ballot(sv[j] >= T); if (lane == j) myw = bal; }
    MASK[(size_t)(b * SEQ + qa) * 64 + lane] = (unsigned)myw;
    MASK[(size_t)(b * SEQ + qa + 1) * 64 + lane] = (unsigned)(myw >> 32);
    LDS_WAIT(); asm volatile("" ::: "memory");
    IDP(6);
}

constexpr int AT_KT = 64 * 256, AT_VP = 144, AT_VT = 128 * AT_VP, AT_BUF = AT_KT + AT_VT;
constexpr int AT_TBL = 2 * AT_BUF;
#define KSWZ(row, colB) ((row) * 256 + ((colB) ^ (((row) & 7) << 4)))
__device__ __forceinline__ int t5_bucket(int n) {
    if (n < 16) return n;
    const int th[16] = {19, 21, 24, 27, 31, 35, 40, 46, 52, 59, 67, 77, 87, 99, 113, 1 << 30};
    int bkt = 16;
#pragma unroll
    for (int i = 0; i < 15; ++i) bkt += (n >= th[i]) ? 1 : 0;
    return bkt;
}
__device__ __forceinline__ void attn_tile(unsigned char* ws, LAS unsigned char* lds, int b, int kvh, int t, int tid_in) {
    int tid = tid_in; asm volatile("" : "+v"(tid));
    const int lane = tid & 63, wave = __builtin_amdgcn_readfirstlane(tid >> 6), r32 = lane & 31, h = lane >> 5;
    const int g = wave >> 1, qs = wave & 1, hq = kvh * 4 + g;
    const int q = 64 * t + 32 * qs + r32;
    ATP(0);
    const unsigned qoff = (unsigned)WS_Q + (unsigned)(((b * SEQ + q) * DM + hq * 128) * 2);
    const unsigned moff = (unsigned)WS_MASK + (unsigned)((b * SEQ + q) * 64 * 4);
    const LAS float* tbl = (const LAS float*)(lds + AT_TBL) + g * 132;
    bf16x8 qr[8];
#pragma unroll
    for (int d0 = 0; d0 < 8; ++d0) qr[d0] = *(const bf16x8*)(ws + qoff + (d0 * 16 + h * 8) * 2);
    const int sr = tid >> 4, sc = (tid & 15) * 8;
    const int vd = tid >> 3, vp = tid & 7;
    const int kws = KSWZ(sr, sc * 2);
    const unsigned koff = (unsigned)WS_K + (unsigned)(((b * SEQ + sr) * KVW + kvh * 128 + sc) * 2);
    const unsigned voff = (unsigned)WS_VT + (unsigned)((((b * 4 + kvh) * 128 + vd) * SEQ + vp * 8) * 2);
    v4u sk0, sk1, sv0, sv1; v2u mw;
#define AT_LOAD(kt) do { const unsigned ko_ = koff + (unsigned)(kt) * (64 * KVW * 2); sk0 = *(const v4u*)(ws + ko_); sk1 = *(const v4u*)(ws + ko_ + 32 * KVW * 2); \
        const unsigned vo_ = voff + (unsigned)(kt) * 128; sv0 = *(const v4u*)(ws + vo_); sv1 = *(const v4u*)(ws + vo_ + 64 * SEQ * 2); } while (0)
#define AT_WRITE(bufo) do { LAS unsigned char* kb_ = lds + (bufo); *(LAS v4u*)(kb_ + kws) = sk0; *(LAS v4u*)(kb_ + kws + 32 * 256) = sk1; \
        LAS unsigned char* vb_ = kb_ + AT_KT + vd * AT_VP + (vp >> 1) * 32 + (vp & 1) * 8; *(LAS v2u*)vb_ = (v2u){sv0.x, sv0.y}; *(LAS v2u*)(vb_ + 16) = (v2u){sv0.z, sv0.w}; \
        *(LAS v2u*)(vb_ + 64 * AT_VP) = (v2u){sv1.x, sv1.y}; *(LAS v2u*)(vb_ + 64 * AT_VP + 16) = (v2u){sv1.z, sv1.w}; } while (0)
    AT_LOAD(0); AT_WRITE(0);
    v2u mwn = *(const v2u*)(ws + moff);
    __syncthreads();
    ATP(6);
    f32x16 o[4];
#pragma unroll
    for (int d = 0; d < 4; ++d)
#pragma unroll
        for (int r = 0; r < 16; ++r) o[d][r] = 0.f;
    float m_run = -1e30f, l_run = 0.f;
    const float C2 = 0.08838834764831845f * LOG2E;
    const float bfar = tbl[128];
    for (int kt = 0; kt <= t; ++kt) {
        const int bufo = (kt & 1) * AT_BUF;
        mw = mwn;
        ATP(0);
        f32x16 p0, p1;
#pragma unroll
        for (int r = 0; r < 16; ++r) { p0[r] = 0.f; p1[r] = 0.f; }
#pragma unroll
        for (int d0 = 0; d0 < 8; ++d0) {
            const LAS unsigned char* a = lds + bufo + KSWZ(r32, (d0 * 16 + h * 8) * 2);
            const bf16x8 a0 = *(const LAS bf16x8*)a, a1 = *(const LAS bf16x8*)(a + 32 * 256);
            p0 = __builtin_amdgcn_mfma_f32_32x32x16_bf16(a0, qr[d0], p0, 0, 0, 0);
            p1 = __builtin_amdgcn_mfma_f32_32x32x16_bf16(a1, qr[d0], p1, 0, 0, 0);
        }
        ATP(1);
        if (kt + 3 > t) {
            const int D0 = q - 64 * kt - 4 * h;
#pragma unroll
            for (int r = 0; r < 16; ++r) {
                const int c = (r & 3) + 8 * (r >> 2);
                unsigned i0 = (unsigned)(D0 - c), i1 = (unsigned)(D0 - 32 - c);
                i0 = i0 > 128u ? 128u : i0; i1 = i1 > 128u ? 128u : i1;
                p0[r] = p0[r] * C2 + tbl[i0]; p1[r] = p1[r] * C2 + tbl[i1];
            }
        } else {
#pragma unroll
            for (int r = 0; r < 16; ++r) { p0[r] = p0[r] * C2 + bfar; p1[r] = p1[r] * C2 + bfar; }
        }
        float mx = p0[0];
#pragma unroll
        for (int r = 1; r < 16; ++r) mx = fmaxf(mx, p0[r]);
#pragma unroll
        for (int r = 0; r < 16; ++r) mx = fmaxf(mx, p1[r]);
        mx = fmaxf(mx, __shfl_xor(mx, 32));
        if (!__all(mx <= m_run + 8.0f)) {
            const float mn = fmaxf(m_run, mx), alpha = fast_exp2(m_run - mn);
            m_run = mn; l_run *= alpha;
#pragma unroll
            for (int d = 0; d < 4; ++d)
#pragma unroll
                for (int r = 0; r < 16; ++r) o[d][r] *= alpha;
        }
        const int wl = (int)(mw.x >> (4 * h)), wh = (int)(mw.y >> (4 * h));
        float ps = 0.f;
#pragma unroll
        for (int r = 0; r < 16; ++r) {
            const int c = (r & 3) + 8 * (r >> 2);
            const unsigned e0 = __builtin_bit_cast(unsigned, fast_exp2(p0[r] - m_run)) & (unsigned)__builtin_amdgcn_sbfe(wl, c, 1);
            const unsigned e1 = __builtin_bit_cast(unsigned, fast_exp2(p1[r] - m_run)) & (unsigned)__builtin_amdgcn_sbfe(wh, c, 1);
            p0[r] = __builtin_bit_cast(float, e0); p1[r] = __builtin_bit_cast(float, e1);
            ps += p0[r] + p1[r];
        }
        l_run += ps;
        ATP(2);
        if (kt < t) { AT_LOAD(kt + 1); mwn = *(const v2u*)(ws + moff + 8u * (unsigned)(kt + 1)); }
        bf16x8 pk[4];
        { v4u w0 = {cvtpk(p0[0], p0[1]), cvtpk(p0[2], p0[3]), cvtpk(p0[4], p0[5]), cvtpk(p0[6], p0[7])}; pk[0] = __builtin_bit_cast(bf16x8, w0);
          v4u w1 = {cvtpk(p0[8], p0[9]), cvtpk(p0[10], p0[11]), cvtpk(p0[12], p0[13]), cvtpk(p0[14], p0[15])}; pk[1] = __builtin_bit_cast(bf16x8, w1);
          v4u w2 = {cvtpk(p1[0], p1[1]), cvtpk(p1[2], p1[3]), cvtpk(p1[4], p1[5]), cvtpk(p1[6], p1[7])}; pk[2] = __builtin_bit_cast(bf16x8, w2);
          v4u w3 = {cvtpk(p1[8], p1[9]), cvtpk(p1[10], p1[11]), cvtpk(p1[12], p1[13]), cvtpk(p1[14], p1[15])}; pk[3] = __builtin_bit_cast(bf16x8, w3); }
        { const LAS unsigned char* vb = lds + bufo + AT_KT + r32 * AT_VP + 16 * h;
#pragma unroll
          for (int dp = 0; dp < 1; ++dp)
#pragma unroll
              for (int ks = 0; ks < 4; ++ks)
#pragma unroll
                  for (int d0 = 0; d0 < 4; ++d0)
                      o[d0] = __builtin_amdgcn_mfma_f32_32x32x16_bf16(*(const LAS bf16x8*)(vb + d0 * 32 * AT_VP + 32 * ks), pk[ks], o[d0], 0, 0, 0); }
        ATP(3);
        if (kt < t) AT_WRITE(((kt + 1) & 1) * AT_BUF);
        ATP(4);
        __syncthreads();
        ATP(5);
    }
    ATP(0);
    const float lt = l_run + __shfl_xor(l_run, 32), rl = 1.0f / lt;
#pragma unroll
    for (int d0 = 0; d0 < 4; ++d0)
#pragma unroll
        for (int gq = 0; gq < 4; ++gq) {
            const v2u w = {cvtpk(o[d0][4 * gq] * rl, o[d0][4 * gq + 1] * rl), cvtpk(o[d0][4 * gq + 2] * rl, o[d0][4 * gq + 3] * rl)};
            *(v2u*)(ws + qoff + (32 * d0 + 8 * gq + 4 * h) * 2) = w;
        }
    ATP(7);
#undef AT_LOAD
#undef AT_WRITE
}
__device__ __forceinline__ void attn_unit(const float* rel_bias, unsigned char* ws, LAS unsigned char* lds, int unit, int tid) {
    const int b = unit >> 6, kvh = (unit >> 4) & 3, p = unit & 15;
    __syncthreads();
    for (int i = tid; i < 4 * 132; i += NTHR) { const int g = i / 132, d = i % 132;
        ((LAS float*)(lds + AT_TBL))[i] = rel_bias[(d >= 128 ? 31 : t5_bucket(d)) * 16 + kvh * 4 + g] * LOG2E; }
    __syncthreads();
    attn_tile(ws, lds, b, kvh, p, tid);
    attn_tile(ws, lds, b, kvh, 31 - p, tid);
}
__device__ __forceinline__ void attn_item(const float* rel_bias, unsigned char* ws, LAS unsigned char* lds, int b, int kvh, int t, int tid) {
    __syncthreads();
    for (int i = tid; i < 4 * 132; i += NTHR) { const int g = i / 132, d = i % 132;
        ((LAS float*)(lds + AT_TBL))[i] = rel_bias[(d >= 128 ? 31 : t5_bucket(d)) * 16 + kvh * 4 + g] * LOG2E; }
    __syncthreads();
    attn_tile(ws, lds, b, kvh, t, tid);
}


#ifndef MK_N_LAUNCHES
#define MK_N_LAUNCHES 1
#endif
constexpr int N_PHASES = 15;
struct Args { const float* in[23]; float* out; unsigned char* ws; int ph_lo, ph_hi; };
static_assert(sizeof(Args) == 23 * 8 + 8 + 8 + 8, "Args has no padding");

#ifndef WGM_DOWN
#define WGM_DOWN 4
#endif
#ifndef WGM_UP
#define WGM_UP 8
#endif
#ifndef WGM_IN
#define WGM_IN 4
#endif
#ifndef WGM_SQ
#define WGM_SQ 8
#endif
#ifndef TAIL_C0
#define TAIL_C0 3072
#endif
__global__ void __launch_bounds__(NTHR, 2) mk_fwd(Args args) {
    extern __shared__ __attribute__((aligned(16))) unsigned char lds_raw[];
    LAS unsigned char* lds = (LAS unsigned char*)lds_raw;
    volatile LAS unsigned* MISC = (volatile LAS unsigned*)(lds + MISC_OFF);
    const int tid = threadIdx.x, lane = tid & 63, wave = __builtin_amdgcn_readfirstlane(tid >> 6);
    const int G = gridDim.x;
    unsigned char* ws = args.ws;
    gu32* ctl = (gu32*)(ws + WS_CTL);
#ifdef PROBE_CLEAR
    for (int u = tid; u < LDS_BYTES / 4; u += NTHR) ((LAS unsigned*)lds)[u] = 0u;
#else
    for (int u = tid; u < (LDS_BYTES - LDSCTL_OFF) / 4; u += NTHR) ((LAS unsigned*)(lds + LDSCTL_OFF))[u] = 0u;
#endif
    __syncthreads();
#if defined(PROBE_P5) || defined(PROBE_P6) || defined(PROBE_PMM)
    if (blockIdx.x == 0 && tid == 0) __hip_atomic_store((unsigned*)ctl + 9064, 0xffffffffu, __ATOMIC_RELAXED, __HIP_MEMORY_SCOPE_AGENT);
#endif
    XcdBarrier bar; bar.bar = (unsigned*)(ctl + CW_BAR); bar.x = 0; bar.st = nullptr;
    const int lo = args.ph_lo, hi = args.ph_hi;
    if (hi - lo > 1) bar = xcd_barrier_post((unsigned*)(ctl + CW_BAR), MISC + 8);
    if (blockIdx.x < 8 && tid == 0) __hip_atomic_store((unsigned*)ctl + 9200 + blockIdx.x, xb_xcc_id() + 1u, __ATOMIC_RELAXED, __HIP_MEMORY_SCOPE_AGENT);
    bool localok = false;
#define IN(k) (lo <= (k) && (k) < hi)
#ifdef PROBE_EPI
#define PHID(k) do { if (blockIdx.x == 0 && tid == 0) MISC[24] = (k); } while (0)
#else
#define PHID(k) do { } while (0)
#endif
#define NEXTP(k) ((k) == 2 ? 4 : ((k) == 6 ? 8 : ((k) == 10 ? 12 : (k) + 1)))
#define BOTH(k) (IN(k) && IN(NEXTP(k)))
#define GRID_BAR(k) do { if (BOTH(k)) xcd_barrier(bar); TS(k); } while (0)
#define LOCAL_BAR(k) do { if (BOTH(k)) { if (localok) xcd_barrier_local(bar); else xcd_barrier(bar); } TS(k); } while (0)
#ifdef PROBE_TSA
    if (blockIdx.x == 0 && tid == 0) { const unsigned long long t_ = rt(); MISC[16] = (unsigned)t_; MISC[17] = (unsigned)(t_ >> 32); }
#define TS(k) do { if (blockIdx.x == 0 && tid == 0) { const unsigned long long now_ = rt(); const unsigned long long prev_ = ((unsigned long long)MISC[17] << 32) | MISC[16]; \
        if ((k) == PROBE_TSA) MISC[20] = (unsigned)(now_ - prev_); if ((k) == PROBE_TSB) MISC[21] = (unsigned)(now_ - prev_); MISC[16] = (unsigned)now_; MISC[17] = (unsigned)(now_ >> 32); } } while (0)
#else
#define TS(k) do { } while (0)
#endif
    const int gw = blockIdx.x * NWAVES + wave, NGW = G * NWAVES;
    LAS float* scr = (LAS float*)(lds + RING_OFF + wave * 16384);
    bf16* XB = (bf16*)(ws + WS_XB);
    bf16* RXp = (bf16*)((unsigned char*)args.out + OUT_RX); bf16* RGp = (bf16*)((unsigned char*)args.out + OUT_RG);
    float* SS1 = (float*)(ws + WS_SS1); float* SS2 = (float*)(ws + WS_SS2);
    LAS float* part = (LAS float*)(lds + XTRA_OFF);

    if (IN(0)) {
        PHID(0);
        { const ConvList L{CV_A0, 2 * IG_FFN, CV_B0, 2 * IG_FFN, CV_C0 + TAIL_C0, N_CONV_ITEMS - (CV_C0 + TAIL_C0)}; conv_list(args.in, ws, L, 0, L.total(), gw, NGW, scr, lane); }
        rms_rows<false>(args.in[0], args.in[1], XB, gw, NGW, lane);
        GRID_BAR(0);
        if (tid == 0 && __hip_atomic_load((unsigned*)ctl + 9200 + (blockIdx.x & 7), __ATOMIC_RELAXED, __HIP_MEMORY_SCOPE_AGENT) != xb_xcc_id() + 1u)
            __hip_atomic_fetch_add((unsigned*)ctl + 9300, 1u, __ATOMIC_RELAXED, __HIP_MEMORY_SCOPE_AGENT);
    }
    if (IN(1)) {
#ifdef PROBE_PMM
        if (PROBE_PMM == 1 && blockIdx.x == 0 && tid == 0) ((volatile unsigned*)ctl)[9128] = (unsigned)rt();
#endif
        PHID(1);
        pg8::Gemm g{XB, (const bf16*)(ws + WS_WGU), MTOK, NGU, DM}; pg8::StaticOrder S; S.init(MTOK, NGU, G, (int)blockIdx.x, WGM_UP);
        EpiSwiGLU<false> E{(bf16*)(ws + WS_ACT), nullptr};
        pg8::gemm_phase<EpiSwiGLU<false>, pg8::StaticOrder, true, true>(lds + RING_OFF, g, S, E);
        {
            const int rem = ((MTOK / 256) * (NGU / 256)) % G;
            if ((int)blockIdx.x >= rem) { __syncthreads();
                const ConvList L{CV_A1, IG_FFN, CV_C0, TAIL_C0, 0, 0}; conv_list(args.in, ws, L, 0, L.total(), ((int)blockIdx.x - rem) * NWAVES + wave, (G - rem) * NWAVES, scr, lane); }
        }
#ifdef PROBE_PMM
        if (PROBE_PMM == 1 && tid == 0) { const unsigned tnow = (unsigned)rt(); __hip_atomic_fetch_max((unsigned*)ctl + 9000, tnow, __ATOMIC_RELAXED, __HIP_MEMORY_SCOPE_AGENT); __hip_atomic_fetch_min((unsigned*)ctl + 9064, tnow, __ATOMIC_RELAXED, __HIP_MEMORY_SCOPE_AGENT); }
#endif
        GRID_BAR(1);
        localok = (hi - lo == N_PHASES) && (G % 8 == 0) && __builtin_amdgcn_readfirstlane((int)__hip_atomic_load((unsigned*)ctl + 9300, __ATOMIC_RELAXED, __HIP_MEMORY_SCOPE_AGENT)) == 0;
    }
    if (IN(2)) {
#ifdef PROBE_PMM
        if (PROBE_PMM == 2 && blockIdx.x == 0 && tid == 0) ((volatile unsigned*)ctl)[9128] = (unsigned)rt();
#endif
        PHID(2);
        pg8::Gemm g{(const bf16*)(ws + WS_ACT), (const bf16*)(ws + WS_WD), MTOK, DM, DFF}; pg8::StaticOrder S; S.init(MTOK, DM, G, (int)blockIdx.x, WGM_DOWN);
        EpiResidB<true> E{args.in[0], XB, 0.5f, SS1, part};
        pg8::gemm_phase<EpiResidB<true>, pg8::StaticOrder, true, true>(lds + RING_OFF, g, S, E);
#ifdef PROBE_PMM
        if (PROBE_PMM == 2 && tid == 0) { const unsigned tnow = (unsigned)rt(); __hip_atomic_fetch_max((unsigned*)ctl + 9000, tnow, __ATOMIC_RELAXED, __HIP_MEMORY_SCOPE_AGENT); __hip_atomic_fetch_min((unsigned*)ctl + 9064, tnow, __ATOMIC_RELAXED, __HIP_MEMORY_SCOPE_AGENT); }
#endif
        LOCAL_BAR(2);
    }
    if (IN(4)) {
#ifdef PROBE_PMM
        if (PROBE_PMM == 4 && blockIdx.x == 0 && tid == 0) ((volatile unsigned*)ctl)[9128] = (unsigned)rt();
#endif
        PHID(4);
        pg8::Gemm g{XB, (const bf16*)(ws + WS_WA), MTOK, NAB, DM}; pg8::StaticOrder S; S.init(MTOK, NAB, G, (int)blockIdx.x, WGM_IN);
        EpiProjA E{ws, RXp, RGp, SS1};
        pg8::gemm_phase<EpiProjA, pg8::StaticOrder, true, true>(lds + RING_OFF, g, S, E);
        for (int u = blockIdx.x; u < MTOK / 64; u += G) ikiw_unit(ws, lds, 32 * (u & 7) + (u >> 3), tid);
#ifdef PROBE_PMM
        if (PROBE_PMM == 4 && tid == 0) { const unsigned tnow = (unsigned)rt(); __hip_atomic_fetch_max((unsigned*)ctl + 9000, tnow, __ATOMIC_RELAXED, __HIP_MEMORY_SCOPE_AGENT); __hip_atomic_fetch_min((unsigned*)ctl + 9064, tnow, __ATOMIC_RELAXED, __HIP_MEMORY_SCOPE_AGENT); }
#endif
        GRID_BAR(4);
    }
    if (IN(5)) {
        PHID(5);
#ifdef PROBE_P5
        if (blockIdx.x == 0 && tid == 0) ((volatile unsigned*)ctl)[9128] = (unsigned)rt();
#endif
        for (int u = blockIdx.x; u < 256; u += G) rnn_unit(args.in, ws, RXp, RGp, lds, u, tid);
#ifdef PROBE_P5
        if (tid == 0) { const unsigned tnow = (unsigned)rt(); __hip_atomic_fetch_max((unsigned*)ctl + 9000, tnow, __ATOMIC_RELAXED, __HIP_MEMORY_SCOPE_AGENT); __hip_atomic_fetch_min((unsigned*)ctl + 9064, tnow, __ATOMIC_RELAXED, __HIP_MEMORY_SCOPE_AGENT); }
#endif
        for (;;) {
            if (tid == 0) MISC[12] = __hip_atomic_fetch_add((unsigned*)ctl + 64, 1u, __ATOMIC_RELAXED, __HIP_MEMORY_SCOPE_AGENT);
            __syncthreads();
            const unsigned item = MISC[12];
            __syncthreads();
            if (item >= 1024u) break;
            const int qb = 127 - (int)(item >> 3), b = (int)(item & 7u);
            idx_scores(ws, lds, b, qb, tid); idx_select(ws, lds, b, qb, tid);
        }
        GRID_BAR(5);
    }
    if (IN(6)) {
        PHID(6);
#ifdef PROBE_P6
        if (blockIdx.x == 0 && tid == 0) ((volatile unsigned*)ctl)[9128] = (unsigned)rt();
#endif
        for (;;) {
            if (tid == 0) MISC[12] = __hip_atomic_fetch_add((unsigned*)ctl + 128, 1u, __ATOMIC_RELAXED, __HIP_MEMORY_SCOPE_AGENT);
            __syncthreads();
            const unsigned item = MISC[12];
            __syncthreads();
            if (item >= 1024u) break;
            attn_item(args.in[14], ws, lds, (int)(item & 7u), (int)((item >> 3) & 3u), 31 - (int)(item >> 5), tid);
        }
#ifdef PROBE_P6
        if (tid == 0) { const unsigned tnow = (unsigned)rt(); __hip_atomic_fetch_max((unsigned*)ctl + 9000, tnow, __ATOMIC_RELAXED, __HIP_MEMORY_SCOPE_AGENT); __hip_atomic_fetch_min((unsigned*)ctl + 9064, tnow, __ATOMIC_RELAXED, __HIP_MEMORY_SCOPE_AGENT); }
#endif
        GRID_BAR(6);
    }
    if (IN(8)) {
        PHID(8);
        pg8::Gemm g{RGp, (const bf16*)(ws + WS_WPR), MTOK, DM, DM}; pg8::StaticOrder S; S.init(MTOK, DM, G, (int)blockIdx.x, WGM_SQ);
        EpiGateMul<false> E{(const bf16*)(ws + WS_SGR), (bf16*)(ws + WS_SGR)};
        pg8::gemm_phase<EpiGateMul<false>, pg8::StaticOrder, true, true>(lds + RING_OFF, g, S, E);
        asm volatile("s_waitcnt vmcnt(0)" ::: "memory"); __syncthreads(); TS(8);
    }
    if (IN(9)) {
        PHID(9);
        pg8::Gemm g{(const bf16*)(ws + WS_Q), (const bf16*)(ws + WS_WPA), MTOK, DM, DM}; pg8::StaticOrder S; S.init(MTOK, DM, G, (int)blockIdx.x, WGM_SQ);
        EpiGateMul<true> E{(const bf16*)(ws + WS_SGA), (bf16*)(ws + WS_SGR)};
        pg8::gemm_phase<EpiGateMul<true>, pg8::StaticOrder, true, true>(lds + RING_OFF, g, S, E);
        LOCAL_BAR(9);
    }
    if (IN(10)) {
        PHID(10);
        pg8::Gemm g{(const bf16*)(ws + WS_SGR), (const bf16*)(ws + WS_WOUT), MTOK, DM, DM}; pg8::StaticOrder S; S.init(MTOK, DM, G, (int)blockIdx.x, WGM_SQ);
        EpiResidB<false> E{nullptr, XB, 1.0f, SS2, part};
        pg8::gemm_phase<EpiResidB<false>, pg8::StaticOrder, true, true>(lds + RING_OFF, g, S, E);
        LOCAL_BAR(10);
    }
    if (IN(12)) {
#ifdef PROBE_PMM
        if (PROBE_PMM == 12 && blockIdx.x == 0 && tid == 0) ((volatile unsigned*)ctl)[9128] = (unsigned)rt();
#endif
        PHID(12);
        pg8::Gemm g{XB, (const bf16*)(ws + WS_WGU2), MTOK, NGU, DM}; pg8::StaticOrder S; S.init(MTOK, NGU, G, (int)blockIdx.x, WGM_UP);
        EpiSwiGLU<true> E{(bf16*)(ws + WS_ACT), SS2};
        pg8::gemm_phase<EpiSwiGLU<true>, pg8::StaticOrder, true, true>(lds + RING_OFF, g, S, E);
        {
            const int rem = ((MTOK / 256) * (NGU / 256)) % G;
            if ((int)blockIdx.x >= rem) { __syncthreads();
                const ConvList L{CV_B1, IG_FFN, 0, 0, 0, 0}; conv_list(args.in, ws, L, 0, L.total(), ((int)blockIdx.x - rem) * NWAVES + wave, (G - rem) * NWAVES, scr, lane); }
        }
#ifdef PROBE_PMM
        if (PROBE_PMM == 12 && tid == 0) { const unsigned tnow = (unsigned)rt(); __hip_atomic_fetch_max((unsigned*)ctl + 9000, tnow, __ATOMIC_RELAXED, __HIP_MEMORY_SCOPE_AGENT); __hip_atomic_fetch_min((unsigned*)ctl + 9064, tnow, __ATOMIC_RELAXED, __HIP_MEMORY_SCOPE_AGENT); }
#endif
        GRID_BAR(12);
    }
    if (IN(13)) {
        PHID(13);
        pg8::Gemm g{(const bf16*)(ws + WS_ACT), (const bf16*)(ws + WS_WD2), MTOK, DM, DFF}; pg8::StaticOrder S; S.init(MTOK, DM, G, (int)blockIdx.x, WGM_DOWN);
        EpiResidB<false> E{nullptr, XB, 0.5f, SS1, part};
        pg8::gemm_phase<EpiResidB<false>, pg8::StaticOrder, true, true>(lds + RING_OFF, g, S, E);
        GRID_BAR(13);
    }
    if (IN(14)) {
        PHID(14);
        rms_out_rows(XB, SS1, args.in[22], args.out, gw, NGW, lane);
#ifdef PROBE_TSA
        TS(14);
#if defined(PROBE_ATT) || defined(PROBE_RNN) || defined(PROBE_IDX)
        if (blockIdx.x == 0 && tid == 0) { const unsigned dA = MISC[40 + PROBE_ATT_A], dB = MISC[40 + PROBE_ATT_B];
#elif defined(PROBE_P5) || defined(PROBE_P6) || defined(PROBE_PMM)
        if (blockIdx.x == 0 && tid == 0) { const unsigned t0p = ((volatile unsigned*)ctl)[9128];
            const unsigned dA = __hip_atomic_load((unsigned*)ctl + 9064, __ATOMIC_RELAXED, __HIP_MEMORY_SCOPE_AGENT) - t0p, dB = __hip_atomic_load((unsigned*)ctl + 9000, __ATOMIC_RELAXED, __HIP_MEMORY_SCOPE_AGENT) - t0p;
#elif defined(PROBE_EPI)
        if (blockIdx.x == 0 && tid == 0) { const unsigned dA = MISC[23] * 1000u, dB = MISC[22];
#else
        if (blockIdx.x == 0 && tid == 0) { const unsigned dA = MISC[20], dB = MISC[21];
#endif
#ifdef PROBE_OFF
            args.out[0] += 1.0f + (float)((int)dA - PROBE_OFF) * 0.001f;
#else
            args.out[0] += 1.0f + (float)dA * 0.001f;
#endif
            const unsigned long long t0_ = rt(), w_ = 8ull * dB; while (rt() - t0_ < w_) __builtin_amdgcn_s_sleep(8); }
#endif
    }
#undef IN
#undef BOTH
#undef NEXTP
#undef GRID_BAR
#undef LOCAL_BAR
#undef TS
}


#if defined(PROBE_DIGEST) || defined(PROBE_P7)
__global__ void final3_k(const unsigned long long* D, float* out, size_t n) {
    const float c = (float)((D[0] != D[1] ? 1 : 0) + (D[1] != D[2] ? 2 : 0));
    for (size_t i = (size_t)blockIdx.x * blockDim.x + threadIdx.x; i < n; i += (size_t)gridDim.x * blockDim.x) out[i] = c;
}
__global__ void digest_k(const v4u* p, size_t n16, const v4u* q, size_t m16, unsigned long long* slot) {
    unsigned long long s = 0ull;
    for (size_t i = (size_t)blockIdx.x * blockDim.x + threadIdx.x; i < n16 + m16; i += (size_t)gridDim.x * blockDim.x) {
        const v4u x = i < n16 ? p[i] : q[i - n16];
        const unsigned long long h = (unsigned long long)i * 0x9E3779B97F4A7C15ull + 0x1234567ull;
        s += ((unsigned long long)x.x * 3ull + (unsigned long long)x.y * 5ull + (unsigned long long)x.z * 7ull + (unsigned long long)x.w * 11ull) * (h | 1ull);
    }
    for (int o = 32; o >= 1; o >>= 1) s += __shfl_xor(s, o);
    if ((threadIdx.x & 63) == 0) atomicAdd(slot, s);
}
__global__ void final_k(const unsigned long long* A, const unsigned long long* B, float* out, size_t n) {
    int k = 0; for (int i = N_PHASES - 1; i >= 0; --i) if (A[i] != B[i]) k = i + 1;
    const float c = (float)k;
    for (size_t i = (size_t)blockIdx.x * blockDim.x + threadIdx.x; i < n; i += (size_t)gridDim.x * blockDim.x) out[i] = c;
}
#endif
extern "C" void kernel_launch(void* const* d_in, const int* in_sizes, int n_in, void* d_out, int out_size, void* d_ws, size_t ws_size, hipStream_t stream) {
    static int grid = 0;
    if (grid == 0) {
        if (n_in != 23 || in_sizes[0] != MTOK * DM || out_size != MTOK * DM || ws_size < WS_END) {
            fprintf(stderr, "kernel_launch: unexpected shapes (n_in %d, in0 %d, out %d, ws %zu); nothing launched\n", n_in, n_in > 0 ? in_sizes[0] : -1, out_size, ws_size); grid = -1; return; }
        int dev = 0, cus = 0, per_cu = 0;
        if (hipGetDevice(&dev) != hipSuccess || hipDeviceGetAttribute(&cus, hipDeviceAttributeMultiprocessorCount, dev) != hipSuccess) { grid = -1; return; }
        if (hipFuncSetAttribute((const void*)mk_fwd, hipFuncAttributeMaxDynamicSharedMemorySize, LDS_BYTES) != hipSuccess) { fprintf(stderr, "kernel_launch: hipFuncSetAttribute failed\n"); grid = -1; return; }
        if (hipOccupancyMaxActiveBlocksPerMultiprocessor(&per_cu, (const void*)mk_fwd, NTHR, LDS_BYTES) != hipSuccess || per_cu < 1)
            fprintf(stderr, "kernel_launch: note: occupancy query reports %d workgroups per CU\n", per_cu);
        (void)hipGetLastError();
        grid = cus;
    }
    if (grid < 0) return;
#ifdef PROBE_CLEAR
    if (hipMemsetAsync((char*)d_ws, 0, WS_END, stream) != hipSuccess) return;
    if (hipMemsetAsync((char*)d_out, 0, (size_t)MTOK * DM * 4, stream) != hipSuccess) return;
#else
    if (hipMemsetAsync((char*)d_ws + WS_CTL, 0, CTL_ZERO_BYTES, stream) != hipSuccess) return;
#endif
    Args a{};
    for (int i = 0; i < 23; ++i) a.in[i] = (const float*)d_in[i];
    a.out = (float*)d_out; a.ws = (unsigned char*)d_ws;
#ifdef PROBE_DIGEST
    unsigned long long* slots = (unsigned long long*)((char*)d_ws + WS_END);
    (void)hipMemsetAsync(slots, 0, 4096, stream);
    for (int run = 0; run < 2; ++run) {
        (void)hipMemsetAsync((char*)d_ws, 0, WS_END, stream);
        (void)hipMemsetAsync((char*)d_out, 0, (size_t)MTOK * DM * 4, stream);
        for (int k = 0; k < N_PHASES; ++k) { a.ph_lo = k; a.ph_hi = k + 1; hipLaunchKernelGGL(mk_fwd, dim3(grid), dim3(NTHR), LDS_BYTES, stream, a);
            hipLaunchKernelGGL(digest_k, dim3(2048), dim3(256), 0, stream, (const v4u*)((char*)d_ws + MiB), (size_t)(WS_END - MiB) / 16, (const v4u*)d_out, (size_t)MTOK * DM * 4 / 16, slots + run * 64 + k); }
    }
    hipLaunchKernelGGL(final_k, dim3(2048), dim3(256), 0, stream, slots, slots + 64, (float*)d_out, (size_t)MTOK * DM);
#elif defined(PROBE_P7)
    unsigned long long* slots = (unsigned long long*)((char*)d_ws + WS_END);
    (void)hipMemsetAsync(slots, 0, 4096, stream);
    (void)hipMemsetAsync((char*)d_ws, 0, WS_END, stream);
    (void)hipMemsetAsync((char*)d_out, 0, (size_t)MTOK * DM * 4, stream);
    for (int k = 0; k < 7; ++k) { a.ph_lo = k; a.ph_hi = k + 1; hipLaunchKernelGGL(mk_fwd, dim3(grid), dim3(NTHR), LDS_BYTES, stream, a); }
    for (int r = 0; r < 3; ++r) { a.ph_lo = 7; a.ph_hi = 8; hipLaunchKernelGGL(mk_fwd, dim3(grid), dim3(NTHR), LDS_BYTES, stream, a);
        hipLaunchKernelGGL(digest_k, dim3(2048), dim3(256), 0, stream, (const v4u*)((char*)d_ws + MiB), (size_t)(WS_END - MiB) / 16, (const v4u*)d_out, (size_t)MTOK * DM * 4 / 16, slots + r); }
    hipLaunchKernelGGL(final3_k, dim3(2048), dim3(256), 0, stream, slots, (float*)d_out, (size_t)MTOK * DM);
#elif MK_N_LAUNCHES == 1
    a.ph_lo = 0; a.ph_hi = N_PHASES;
    hipLaunchKernelGGL(mk_fwd, dim3(grid), dim3(NTHR), LDS_BYTES, stream, a);
#else
    for (int k = 0; k < N_PHASES; ++k) { a.ph_lo = k; a.ph_hi = k + 1; hipLaunchKernelGGL(mk_fwd, dim3(grid), dim3(NTHR), LDS_BYTES, stream, a); }
#endif
}
```
